# Optimizing an MI355X kernel written in HIP

```python
import math
import jax, jax.numpy as jnp
from jax import lax
import numpy as np

D_MODEL = 2048
BATCH = 4
SEQ = 8192
DEPTH = 2
DEC_BATCH = 32
DEC_SEQ = 64
PAST_LEN = 1024

CHUNK = 64
N_MIXERS = 2
POOL_WINDOWS = (2, 4, 8, 16)
N_POOL_GROUPS = len(POOL_WINDOWS)
POOL_GW = D_MODEL // N_POOL_GROUPS
POOL_STATE = max(POOL_WINDOWS) - 1
N_HEADS = 8
HEAD_HALF = D_MODEL // (2 * N_HEADS)
HEAD_DIM = 2 * HEAD_HALF
D_FF = -(-8 * D_MODEL // (3 * 256)) * 256
Q_BLOCK = 128
EPS = 1e-6
NEG_INF = -1e30

kernel_name = "hybrid_pool_diffattn_stream_step"


def rms_norm(x, g):
    xf = x.astype(jnp.float32)
    y = xf * lax.rsqrt(jnp.mean(xf * xf, axis=-1, keepdims=True) + EPS)
    return (y * g.astype(jnp.float32)).astype(x.dtype)


def alibi_slopes():
    h = jnp.arange(1, N_HEADS + 1, dtype=jnp.float32)
    return 2.0 ** (-8.0 * h / N_HEADS)


def swiglu(x, g, w_gate, w_up, w_down):
    h = rms_norm(x, g)
    return (jax.nn.silu(h @ w_gate) * (h @ w_up)) @ w_down


def pool_mixer(u, prefix, n_valid_prefix, pool_w, pool_b, pool_scale):
    B, T, _ = u.shape
    uf = u.astype(jnp.float32)
    ext = jnp.concatenate([prefix.astype(jnp.float32), uf], axis=1)
    cs = jnp.concatenate([jnp.zeros((B, 1, D_MODEL), jnp.float32),
                          jnp.cumsum(ext, axis=1)], axis=1)
    t = jnp.arange(T, dtype=jnp.int32)
    groups = []
    for g, w in enumerate(POOL_WINDOWS):
        c0, c1 = g * POOL_GW, (g + 1) * POOL_GW
        hi = cs[:, POOL_STATE + 1:POOL_STATE + 1 + T, c0:c1]
        lo = cs[:, POOL_STATE + 1 - w:POOL_STATE + 1 - w + T, c0:c1]
        cnt = jnp.minimum(w, t + 1 + n_valid_prefix).astype(jnp.float32)
        groups.append((hi - lo) / cnt[None, :, None])
    pooled = jnp.concatenate(groups, axis=-1) - uf
    mixed = jnp.einsum('btgc,gcd->btgd',
                       pooled.reshape(B, T, N_POOL_GROUPS, POOL_GW),
                       pool_w.astype(jnp.float32)).reshape(B, T, D_MODEL)
    out = (mixed + pool_b.astype(jnp.float32)) * pool_scale.astype(jnp.float32)
    new_state = ext[:, -POOL_STATE:]
    return out.astype(u.dtype), new_state.astype(u.dtype)


def diff_attend(q, k, v, q_pos, k_pos, lam):
    s = jnp.einsum('bqhcd,bkhcd->bhcqk', q.astype(jnp.float32),
                   k.astype(jnp.float32)) * (HEAD_HALF ** -0.5)
    dist = jnp.abs(q_pos[:, None] - k_pos[None, :]).astype(jnp.float32)
    bias = -alibi_slopes()[:, None, None] * dist
    visible = (k_pos[None, :] // CHUNK) <= (q_pos[:, None] // CHUNK)
    s = jnp.where(visible, s + bias[None, :, None], NEG_INF)
    p = jax.nn.softmax(s, axis=-1)
    a = p[:, :, 0] - lam * p[:, :, 1]
    return jnp.einsum('bhqk,bkhe->bqhe', a, v.astype(jnp.float32))


def diff_attn_mixer(u, past_k, past_v, lam_init, w_qkv, q_norm, k_norm,
                    lambda_q1, lambda_k1, lambda_q2, lambda_k2, subln, w_o):
    B, T, _ = u.shape
    q, k, v = jnp.split(u @ w_qkv, 3, axis=-1)
    q = rms_norm(q.reshape(B, T, N_HEADS, 2, HEAD_HALF), q_norm)
    k = rms_norm(k.reshape(B, T, N_HEADS, 2, HEAD_HALF), k_norm)
    v = v.reshape(B, T, N_HEADS, HEAD_DIM)
    f32 = jnp.float32
    lam = (jnp.exp(jnp.sum(lambda_q1.astype(f32) * lambda_k1.astype(f32)))
           - jnp.exp(jnp.sum(lambda_q2.astype(f32) * lambda_k2.astype(f32))) + lam_init)
    if past_k is None:
        n_blk = T // Q_BLOCK
        qb = q.reshape(B, n_blk, Q_BLOCK, N_HEADS, 2, HEAD_HALF).swapaxes(0, 1)
        k_pos = jnp.arange(T, dtype=jnp.int32)

        def one_block(args):
            qi, bi = args
            q_pos = bi * Q_BLOCK + jnp.arange(Q_BLOCK, dtype=jnp.int32)
            return diff_attend(qi, k, v, q_pos, k_pos, lam)

        o = lax.map(one_block, (qb, jnp.arange(n_blk, dtype=jnp.int32)))
        o = o.swapaxes(0, 1).reshape(B, T, N_HEADS, HEAD_DIM)
    else:
        P = past_k.shape[1]
        kk = jnp.concatenate([past_k.reshape(B, P, N_HEADS, 2, HEAD_HALF).astype(k.dtype), k], axis=1)
        vv = jnp.concatenate([past_v.astype(v.dtype), v], axis=1)
        q_pos = P + jnp.arange(T, dtype=jnp.int32)
        k_pos = jnp.arange(P + T, dtype=jnp.int32)
        o = diff_attend(q, kk, vv, q_pos, k_pos, lam)
    o = rms_norm(o, subln) * (1.0 - lam_init)
    y = o.reshape(B, T, D_MODEL).astype(u.dtype) @ w_o
    return y, k.reshape(B, T, N_HEADS, HEAD_DIM), v


def run_trunk(x, pool_prefix, n_valid_prefix, past_k, past_v, norm_mix, norm_ffn,
              pool_w, pool_b, pool_scale, w_qkv, q_norm, k_norm,
              lambda_q1, lambda_k1, lambda_q2, lambda_k2, subln, w_o,
              w_gate, w_up, w_down):
    pool_state = k_new = v_new = None
    for i in range(DEPTH):
        u = rms_norm(x, norm_mix[i])
        if i % N_MIXERS == 0:
            y, pool_state = pool_mixer(u, pool_prefix, n_valid_prefix, pool_w, pool_b, pool_scale)
        else:
            lam_init = 0.8 - 0.6 * math.exp(-0.3 * i)
            y, k_new, v_new = diff_attn_mixer(u, past_k, past_v, lam_init, w_qkv, q_norm, k_norm,
                                              lambda_q1, lambda_k1, lambda_q2, lambda_k2, subln, w_o)
        x = x + y.astype(x.dtype)
        x = x + swiglu(x, norm_ffn[i], w_gate[i], w_up[i], w_down[i]).astype(x.dtype)
    return x, pool_state, k_new, v_new


def setup_inputs(seed: int = 0) -> dict:
    key = jax.random.key(seed)
    ks = jax.random.split(key, 24)
    f32 = jnp.float32
    nrm = lambda k, shape, s: jax.random.normal(k, shape, f32) * s
    return {
        "x_prompt": nrm(ks[0], (BATCH, SEQ, D_MODEL), 1.0),
        "x_sample": nrm(ks[1], (DEC_BATCH, DEC_SEQ, D_MODEL), 1.0),
        "state_pool": nrm(ks[2], (DEC_BATCH, POOL_STATE, D_MODEL), 1.0),
        "cache_k": nrm(ks[3], (DEC_BATCH, PAST_LEN, N_HEADS, HEAD_DIM), 1.0),
        "cache_v": nrm(ks[4], (DEC_BATCH, PAST_LEN, N_HEADS, HEAD_DIM), 1.0),
        "norm_mix": 1.0 + nrm(ks[5], (DEPTH, D_MODEL), 0.05),
        "norm_ffn": 1.0 + nrm(ks[6], (DEPTH, D_MODEL), 0.05),
        "pool_w": nrm(ks[7], (N_POOL_GROUPS, POOL_GW, POOL_GW), POOL_GW ** -0.5),
        "pool_b": nrm(ks[8], (D_MODEL,), 0.02),
        "pool_scale": 1.0 + nrm(ks[9], (D_MODEL,), 0.1),
        "w_qkv": nrm(ks[10], (D_MODEL, 3 * D_MODEL), D_MODEL ** -0.5),
        "q_norm": 1.0 + nrm(ks[11], (HEAD_HALF,), 0.05),
        "k_norm": 1.0 + nrm(ks[12], (HEAD_HALF,), 0.05),
        "lambda_q1": nrm(ks[13], (HEAD_HALF,), 0.1),
        "lambda_k1": nrm(ks[14], (HEAD_HALF,), 0.1),
        "lambda_q2": nrm(ks[15], (HEAD_HALF,), 0.1),
        "lambda_k2": nrm(ks[16], (HEAD_HALF,), 0.1),
        "subln": 1.0 + nrm(ks[17], (HEAD_DIM,), 0.05),
        "w_o": nrm(ks[18], (D_MODEL, D_MODEL), D_MODEL ** -0.5),
        "w_gate": nrm(ks[19], (DEPTH, D_MODEL, D_FF), D_MODEL ** -0.5),
        "w_up": nrm(ks[20], (DEPTH, D_MODEL, D_FF), D_MODEL ** -0.5),
        "w_down": nrm(ks[21], (DEPTH, D_FF, D_MODEL), D_FF ** -0.5),
    }


def reference(x_prompt, x_sample, state_pool, cache_k, cache_v, norm_mix, norm_ffn,
              pool_w, pool_b, pool_scale, w_qkv, q_norm, k_norm,
              lambda_q1, lambda_k1, lambda_q2, lambda_k2, subln, w_o,
              w_gate, w_up, w_down):
    weights = (norm_mix, norm_ffn, pool_w, pool_b, pool_scale, w_qkv, q_norm, k_norm,
               lambda_q1, lambda_k1, lambda_q2, lambda_k2, subln, w_o, w_gate, w_up, w_down)
    zero_prefix = jnp.zeros((x_prompt.shape[0], POOL_STATE, D_MODEL), x_prompt.dtype)
    y_prompt, pool_state_prompt, k_prompt, v_prompt = run_trunk(
        x_prompt, zero_prefix, 0, None, None, *weights)
    y_sample, pool_state_sample, k_sample, v_sample = run_trunk(
        x_sample, state_pool, POOL_STATE, cache_k, cache_v, *weights)
    return (y_prompt, y_sample, pool_state_prompt, pool_state_sample,
            k_prompt, v_prompt, k_sample, v_sample)
```

```cpp
#include <hip/hip_runtime.h>
#include <cstdio>
#include <cstdint>

#ifndef MK_N_LAUNCHES
#define MK_N_LAUNCHES 1
#endif

#define LAS __attribute__((address_space(3)))
typedef unsigned short bf16_t;
typedef short bf16x8 __attribute__((ext_vector_type(8)));
typedef short s16x4 __attribute__((ext_vector_type(4)));
typedef float f32x4 __attribute__((ext_vector_type(4)));
typedef float f32x2 __attribute__((ext_vector_type(2)));
typedef float f32x16 __attribute__((ext_vector_type(16)));
typedef unsigned u32x4 __attribute__((ext_vector_type(4)));
typedef unsigned u32x2 __attribute__((ext_vector_type(2)));

constexpr int DM = 2048, NB = 4, SEQ = 8192, DB = 32, DS = 64, PAST = 1024, NH = 8, HD = 256, HH = 128, DFF = 5632, PST = 15;
constexpr int MP = NB * SEQ, MS = DB * DS, M = MP + MS;
constexpr float EPS = 1e-6f;
constexpr float LAM_INIT = 0.35550907f;
constexpr float QSCALE = 0.08838834764831845f * 1.4426950408889634f;
constexpr size_t O_Y = 0, O_PSP = (size_t)M * DM, O_PSS = O_PSP + (size_t)NB * PST * DM, O_KP = O_PSS + (size_t)DB * PST * DM,
                 O_VP = O_KP + (size_t)MP * DM, O_KS = O_VP + (size_t)MP * DM, O_VS = O_KS + (size_t)MS * DM, O_END = O_VS + (size_t)MS * DM;
constexpr size_t MiB = 1u << 20;
constexpr size_t WS_CTL = 0, CTL_ZERO_BYTES = 1 * MiB, WS_RSTD = 1 * MiB, WS_WPOOL = 2 * MiB, WS_WQKV = 4 * MiB, WS_WO = 28 * MiB, WS_WGU = 36 * MiB,
                 WS_WD = 124 * MiB, WS_U = 168 * MiB, WS_H = 304 * MiB, WS_Q = 304 * MiB, WS_K = 440 * MiB, WS_V = 576 * MiB, WS_CK = 712 * MiB,
                 WS_CV = 840 * MiB, WS_SCR = 968 * MiB, WS_END = 1032 * MiB;
static_assert(WS_K - WS_Q == WS_V - WS_K && WS_H + (size_t)M * DFF * 2 <= WS_CK && WS_U + (size_t)M * DM * 2 <= WS_H && WS_WD + 2 * (size_t)DM * DFF * 2 <= WS_U, "ws map");
constexpr int CW_BAR = 4096, CW_Q = 16384, CW_SS = 32768;
constexpr int RING_BYTES = 131072, SSL_OFF = RING_BYTES  , LDSX_OFF = 147456, LDSX_BYTES = 8192, MISC_OFF = LDSX_OFF + LDSX_BYTES, LDS_BYTES = 163840;

__device__ __forceinline__ unsigned cvt_pk_bf16(float lo, float hi) { unsigned r; asm volatile("v_cvt_pk_bf16_f32 %0, %1, %2" : "=v"(r) : "v"(lo), "v"(hi)); return r; }
__device__ __forceinline__ int lane_id_v() { int x; asm volatile("v_mbcnt_lo_u32_b32 %0, -1, 0\n\tv_mbcnt_hi_u32_b32 %0, -1, %0" : "=v"(x)); return x; }
template <int K> __device__ __forceinline__ float shx(float v) { return __int_as_float(__builtin_amdgcn_ds_swizzle(__float_as_int(v), (K << 10) | 0x1F)); }
__device__ __forceinline__ float add_x32(float v) { auto rr = __builtin_amdgcn_permlane32_swap(__float_as_uint(v), __float_as_uint(v), false, false); return __uint_as_float(rr[0]) + __uint_as_float(rr[1]); }
__device__ __forceinline__ float max_x32(float v) { auto rr = __builtin_amdgcn_permlane32_swap(__float_as_uint(v), __float_as_uint(v), false, false); return fmaxf(__uint_as_float(rr[0]), __uint_as_float(rr[1])); }
__device__ __forceinline__ float wave_sum(float v) { v += shx<1>(v); v += shx<2>(v); v += shx<4>(v); v += shx<8>(v); v += shx<16>(v); return add_x32(v); }
__device__ __forceinline__ float wave_max(float v) { v = fmaxf(v, shx<1>(v)); v = fmaxf(v, shx<2>(v)); v = fmaxf(v, shx<4>(v)); v = fmaxf(v, shx<8>(v)); v = fmaxf(v, shx<16>(v)); return max_x32(v); }
#define LDS_WAIT() asm volatile("s_waitcnt lgkmcnt(0)" ::: "memory")
typedef unsigned long long u64;
constexpr float SS_SCALE = 16777216.0f, SS_INV = 1.0f / 16777216.0f;
__device__ __forceinline__ float rstd_of(u64 s) { return __builtin_amdgcn_rsqf((float)s * (SS_INV / DM) + EPS); }
__device__ __forceinline__ void ss_add(u64* p, float s) { (void)__hip_atomic_fetch_add(p, (u64)(s * SS_SCALE), __ATOMIC_RELAXED, __HIP_MEMORY_SCOPE_AGENT); }
__device__ __forceinline__ float bf_lo(unsigned w) { return __uint_as_float(w << 16); }
__device__ __forceinline__ float bf_hi(unsigned w) { return __uint_as_float(w & 0xffff0000u); }

namespace pg8 {
#define PG8_LAS __attribute__((address_space(3)))
constexpr int BM = 256, BK = 64, HALF = 128, HTB = HALF * BK * 2, STAGE_BYTES = 8 * HTB, NXCD = 8, WGM = 4;
__host__ __device__ __forceinline__ int lds_byte(int r, int c) { const int st = (r >> 4) * 2 + (c >> 5), rr = r & 15, cc = c & 31, ob = rr * 64 + cc * 2; return st * 1024 + (ob ^ (((ob >> 9) & 1) << 5)); }
__host__ __device__ __forceinline__ void stage_rc(int b, int& R, int& C) { const int st = b / 1024, sb = b % 1024, swz = sb ^ (((sb >> 9) & 1) << 5); R = (st >> 1) * 16 + swz / 64; C = (st & 1) * 32 + (swz % 64) / 2; }
__host__ __device__ __forceinline__ int perm32(int rho) { const int n = rho >> 4, i = rho & 15; return 8 * (i >> 2) + 4 * n + (i & 3); }

struct Unit { int pm, pn, kq, half; };
struct Gemm { const bf16_t* A; const bf16_t* Bt; int lda, ldb, K, a_div, a_mul; };

struct StaticOrder {
    int nM, nN, nwg, G, c, nMs, ksp, hs;
    __host__ __device__ void init(int M_, int N_, int G_, int c_, int nMs_ = 0, int ksp_ = 1, int hs_ = 0) { nMs = nMs_; ksp = ksp_; nM = M_ / BM - nMs; nN = N_ / BM; nwg = nM * nN; G = G_; c = c_; hs = hs_; }
    __host__ __device__ bool next(int i, Unit& u) const {
        long L = (long)i * G + c; u.half = -1;
        if (hs) { const int fr_ = nwg / G, rem = nwg - fr_ * G;
            if (i == fr_ && 2 * rem <= G) { if (c >= 2 * rem) return false; L = (long)fr_ * G + (c >> 1); u.half = c & 1; } }
        if (L >= nwg + (long)nMs * nN * ksp) return false;
        if (L >= nwg) { const int s_ = (int)(L - nwg), rest = s_ / ksp; u.kq = s_ - rest * ksp; u.pn = rest % nN; u.pm = nM + rest / nN; return true; }
        int wgid = (int)L; { const int q = nwg / NXCD, r = nwg % NXCD, xcd = wgid % NXCD, off = wgid / NXCD; wgid = (xcd < r ? xcd * (q + 1) : r * (q + 1) + (xcd - r) * q) + off; }
        const int nig = WGM * nN, gid = wgid / nig, fm = gid * WGM, gsz = (nM - fm) < WGM ? (nM - fm) : WGM;
        u.pm = fm + ((wgid % nig) % gsz); u.pn = (wgid % nig) / gsz; u.kq = -1; return true;
    }
};

template <class Epi>
__device__ __forceinline__ void gemm_phase(PG8_LAS unsigned char* lds, const Gemm g, const StaticOrder& S, const Epi& E, int wv) {
    int tid = (wv << 6) | lane_id_v(); asm volatile("" : "+v"(tid));
    const int wid = __builtin_amdgcn_readfirstlane(tid >> 6), lane = tid & 63, wr = wid >> 2, wc = wid & 3, fr = lane & 15, fq = lane >> 4;
    const int K = g.K;
    unsigned voffA[2], voffB[2];
#pragma unroll
    for (int i = 0; i < 2; ++i) { int R, C; stage_rc(tid * 16 + i * 8192, R, C); const int Rb = Epi::PERM ? ((R & ~31) + perm32(R & 31)) : R;
        voffA[i] = (unsigned)(R * g.lda + C) * 2u; voffB[i] = (unsigned)(Rb * g.ldb + C) * 2u; }
    const size_t kstep = (size_t)(BK * 2);
    const size_t hstepA = (size_t)HALF * g.lda * 2, hstepB = (size_t)HALF * g.ldb * 2;
    const unsigned ldsw = (unsigned)wid * 1024u;
    const int aoff = lds_byte(wr * 64 + fr, fq * 8), boff = lds_byte(wc * 32 + fr, fq * 8);
#define PG8_KOFS(u) ((u).kq < 0 ? 0 : (u).kq * (K / S.ksp))
#define PG8_NT(u) ((u).kq < 0 ? K / BK : K / S.ksp / BK)
#define PG8_APTR(u) ((const char*)g.A + ((size_t)(u).pm * BM * g.lda + (size_t)((u).pn / g.a_div) * g.a_mul + PG8_KOFS(u) + ((Epi::HALF_OK && (u).half > 0) ? (size_t)HALF * g.lda : (size_t)0)) * 2)
#define PG8_HST(u) ((Epi::HALF_OK && (u).half >= 0) ? (size_t)0 : hstepA)
#define PG8_BPTR(u) ((const char*)g.Bt + ((size_t)(u).pn * BM * g.ldb + PG8_KOFS(u)) * 2)
#define PG8_SA(b, h) (((b) * 2 + (h)) * HTB)
#define PG8_SB(b, h) ((4 + (b) * 2 + (h)) * HTB)
#define PG8_STAGE(bufoff, gbase, voff) do { _Pragma("unroll") for (int _i = 0; _i < 2; ++_i) \
        __builtin_amdgcn_global_load_lds((const unsigned*)((const char*)(gbase) + (voff)[_i]), (PG8_LAS unsigned*)(lds + (bufoff) + ldsw + _i * 8192), 16, 0, 0); } while (0)
#define PG8_LDA(dst, b, h) do { _Pragma("unroll") for (int m = 0; m < 4; ++m) _Pragma("unroll") for (int k = 0; k < 2; ++k) dst[m][k] = *(const PG8_LAS bf16x8*)(lds + PG8_SA(b, h) + aoff + m * 2048 + k * 1024); } while (0)
#define PG8_LDB(dst, b, h) do { _Pragma("unroll") for (int n = 0; n < 2; ++n) _Pragma("unroll") for (int k = 0; k < 2; ++k) dst[n][k] = *(const PG8_LAS bf16x8*)(lds + PG8_SB(b, h) + boff + n * 2048 + k * 1024); } while (0)
#define PG8_MMA(ai, bj, At, Bt) do { __builtin_amdgcn_s_setprio(1); _Pragma("unroll") for (int m = 0; m < 4; ++m) _Pragma("unroll") for (int n = 0; n < 2; ++n) _Pragma("unroll") for (int k = 0; k < 2; ++k) \
        acc[ai][bj][m][n] = __builtin_amdgcn_mfma_f32_16x16x32_bf16(Bt[n][k], At[m][k], acc[ai][bj][m][n], 0, 0, 0); __builtin_amdgcn_s_setprio(0); } while (0)
#define PG8_WAIT_V(n) asm volatile("s_waitcnt vmcnt(" #n ")" ::: "memory")
#define PG8_WAIT_L(n) asm volatile("s_waitcnt lgkmcnt(" #n ")" ::: "memory")
#define PG8_BAR __builtin_amdgcn_s_barrier()
#define PG8_SCHED __builtin_amdgcn_sched_barrier(0)
    Unit cur, nxt; int ui = 0;
    if (!S.next(0, cur)) return;
    f32x4 acc[2][2][4][2];
#pragma unroll
    for (int a = 0; a < 2; ++a)
#pragma unroll
        for (int b = 0; b < 2; ++b)
#pragma unroll
            for (int m = 0; m < 4; ++m)
#pragma unroll
                for (int n = 0; n < 2; ++n) acc[a][b][m][n] = (f32x4){0.f, 0.f, 0.f, 0.f};
    bf16x8 At[4][2], B0[2][2], B1[2][2];
    const char* cA = PG8_APTR(cur); const char* cB = PG8_BPTR(cur);
    PG8_STAGE(PG8_SB(0, 0), cB, voffB); PG8_STAGE(PG8_SB(0, 1), cB + hstepB, voffB); PG8_STAGE(PG8_SA(0, 0), cA, voffA); PG8_STAGE(PG8_SA(0, 1), cA + hstepA, voffA);
    if (wr == 1) PG8_BAR;
    PG8_WAIT_V(2); PG8_BAR;
    PG8_STAGE(PG8_SB(1, 0), cB + kstep, voffB); PG8_STAGE(PG8_SA(1, 0), cA + kstep, voffA); PG8_STAGE(PG8_SB(1, 1), cB + hstepB + kstep, voffB);
    PG8_WAIT_V(6); PG8_BAR;
    for (;;) {
        if (Epi::SS_LDS) {
            __builtin_amdgcn_global_load_lds((const unsigned*)((const char*)(E.ss + (size_t)cur.pm * BM) + wid * 256 + lane * 4), (PG8_LAS unsigned*)(lds + SSL_OFF + (ui & 1) * 2048 + wid * 256), 4, 0, 0); }
        const bool has_next = S.next(ui + 1, nxt);
        const char* nA = has_next ? PG8_APTR(nxt) : cA; const char* nB = has_next ? PG8_BPTR(nxt) : cB;
        const int nt = PG8_NT(cur);
        const bool hm = Epi::HALF_OK && cur.half >= 0;
        const size_t nhs = has_next ? PG8_HST(nxt) : PG8_HST(cur);
#define PG8_KLOOP(HM, CHS) \
        for (int t = 0; t < nt; t += 2) { \
            const bool last = (t == nt - 2); \
            const char* a1 = cA + (size_t)(t + 1) * kstep; \
            const char* a2 = last ? nA : cA + (size_t)(t + 2) * kstep; const char* b2 = last ? nB : cB + (size_t)(t + 2) * kstep; \
            const char* a3 = a2 + kstep; const char* b3 = b2 + kstep; \
              \
            PG8_LDB(B0, 0, 0); PG8_LDB(B1, 0, 1); PG8_SCHED; PG8_LDA(At, 0, 0); PG8_STAGE(PG8_SA(1, 1), a1 + (CHS), voffA); \
            PG8_WAIT_V(8); PG8_WAIT_L(0); PG8_BAR; PG8_MMA(0, 0, At, B0); PG8_MMA(0, 1, At, B1); PG8_BAR; PG8_SCHED; \
              \
            if (!(HM)) PG8_LDA(At, 0, 1); \
            PG8_STAGE(PG8_SB(0, 0), b2, voffB); PG8_STAGE(PG8_SB(0, 1), b2 + hstepB, voffB); PG8_STAGE(PG8_SA(0, 0), a2, voffA); \
            PG8_WAIT_V(8); PG8_WAIT_L(0); PG8_BAR; if (!(HM)) { PG8_MMA(1, 0, At, B0); PG8_MMA(1, 1, At, B1); } PG8_BAR; PG8_SCHED; \
              \
            PG8_LDB(B0, 1, 0); PG8_LDB(B1, 1, 1); PG8_SCHED; PG8_LDA(At, 1, 0); PG8_STAGE(PG8_SA(0, 1), a2 + (last ? nhs : (CHS)), voffA); \
            PG8_WAIT_V(8); PG8_WAIT_L(0); PG8_BAR; PG8_MMA(0, 0, At, B0); PG8_MMA(0, 1, At, B1); PG8_BAR; PG8_SCHED; \
              \
            if (!(HM)) PG8_LDA(At, 1, 1); \
            PG8_STAGE(PG8_SB(1, 0), b3, voffB); PG8_STAGE(PG8_SB(1, 1), b3 + hstepB, voffB); PG8_STAGE(PG8_SA(1, 0), a3, voffA); \
            PG8_WAIT_V(8); PG8_WAIT_L(0); PG8_BAR; if (!(HM)) { PG8_MMA(1, 0, At, B0); PG8_MMA(1, 1, At, B1); } PG8_BAR; PG8_SCHED; \
        }
        if (hm) { PG8_KLOOP(true, (size_t)0) } else { PG8_KLOOP(false, hstepA) }
#undef PG8_KLOOP
        if (wr == 0) PG8_BAR;
        E(acc, cur, wr, wc, fr, fq, (const PG8_LAS u64*)(lds + SSL_OFF + (ui & 1) * 2048));
        if (!has_next) break;
#pragma unroll
        for (int a = 0; a < 2; ++a)
#pragma unroll
            for (int b = 0; b < 2; ++b)
#pragma unroll
                for (int m = 0; m < 4; ++m)
#pragma unroll
                    for (int n = 0; n < 2; ++n) acc[a][b][m][n] = (f32x4){0.f, 0.f, 0.f, 0.f};
        cur = nxt; cA = nA; cB = nB; ++ui;
        if (wr == 1) PG8_BAR;
    }
    PG8_WAIT_V(0);
    PG8_BAR;
#undef PG8_KOFS
#undef PG8_NT
#undef PG8_APTR
#undef PG8_HST
#undef PG8_BPTR
#undef PG8_SA
#undef PG8_SB
#undef PG8_STAGE
#undef PG8_LDA
#undef PG8_LDB
#undef PG8_MMA
#undef PG8_WAIT_V
#undef PG8_WAIT_L
#undef PG8_BAR
#undef PG8_SCHED
}

struct EpiPool {
    static constexpr bool PERM = true, SS_LDS = false, HALF_OK = false;
    const float* xp; const float* xs; bf16_t* Xb; u64* ss; const float* pb; const float* ps;
    __device__ __forceinline__ void operator()(const f32x4 (&acc)[2][2][4][2], const Unit& u, int wr, int wc, int fr, int fq, const PG8_LAS u64* ssl) const {
        const int row0 = u.pm * BM + wr * 64 + fr, col0 = u.pn * BM + wc * 32 + 8 * fq;
        const float* xin = ((u.pm < MP / BM) ? xp : xs - (size_t)MP * DM) + (size_t)row0 * DM + col0;
        bf16_t* xo = Xb + (size_t)row0 * DM + col0; u64* sp = ss + row0;
        f32x4 bv[2][2], sv[2][2];
#pragma unroll
        for (int bj = 0; bj < 2; ++bj)
#pragma unroll
            for (int n = 0; n < 2; ++n) { bv[bj][n] = *(const f32x4*)(pb + col0 + bj * HALF + 4 * n); sv[bj][n] = *(const f32x4*)(ps + col0 + bj * HALF + 4 * n); }
#pragma unroll
        for (int ai = 0; ai < 2; ++ai) {
            f32x4 xv[4][2][2];
#pragma unroll
            for (int m = 0; m < 4; ++m)
#pragma unroll
                for (int bj = 0; bj < 2; ++bj)
#pragma unroll
                    for (int n = 0; n < 2; ++n) xv[m][bj][n] = *(const f32x4*)(xin + (size_t)(ai * HALF + m * 16) * DM + bj * HALF + 4 * n);
            asm volatile("" ::: "memory");
#pragma unroll
            for (int m = 0; m < 4; ++m) { float s = 0.f;
#pragma unroll
                for (int bj = 0; bj < 2; ++bj) {
                    const f32x4 y0 = xv[m][bj][0] + (acc[ai][bj][m][0] + bv[bj][0]) * sv[bj][0], y1 = xv[m][bj][1] + (acc[ai][bj][m][1] + bv[bj][1]) * sv[bj][1];
                    s += (y0[0] * y0[0] + y0[1] * y0[1]) + (y0[2] * y0[2] + y0[3] * y0[3]) + (y1[0] * y1[0] + y1[1] * y1[1]) + (y1[2] * y1[2] + y1[3] * y1[3]);
                    u32x4 w; w.x = cvt_pk_bf16(y0[0], y0[1]); w.y = cvt_pk_bf16(y0[2], y0[3]); w.z = cvt_pk_bf16(y1[0], y1[1]); w.w = cvt_pk_bf16(y1[2], y1[3]);
                    *(u32x4*)(xo + (size_t)(ai * HALF + m * 16) * DM + bj * HALF) = w; }
                s += shx<16>(s); s = add_x32(s);
                if (fq == 0) ss_add(sp + ai * HALF + m * 16, s); }
            asm volatile("" ::: "memory"); }
    }
};
struct EpiRes {
    static constexpr bool PERM = true, SS_LDS = false, HALF_OK = false;
    bf16_t* Xb; u64* ss; float* P; float* Yf;
    __device__ __forceinline__ void operator()(const f32x4 (&acc)[2][2][4][2], const Unit& u, int wr, int wc, int fr, int fq, const PG8_LAS u64* ssl) const {
        const int row0 = u.pm * BM + wr * 64 + fr, col0 = u.pn * BM + wc * 32 + 8 * fq;
        if (u.kq >= 0) {
            float* pb = P + ((size_t)u.kq * MS - MP) * DM + (size_t)row0 * DM + col0;
#pragma unroll
            for (int ai = 0; ai < 2; ++ai)
#pragma unroll
                for (int m = 0; m < 4; ++m)
#pragma unroll
                    for (int bj = 0; bj < 2; ++bj)
#pragma unroll
                        for (int n = 0; n < 2; ++n) *(f32x4*)(pb + (size_t)(ai * HALF + m * 16) * DM + bj * HALF + 4 * n) = acc[ai][bj][m][n];
            return;
        }
        bf16_t* xo = Xb + (size_t)row0 * DM + col0; u64* sp = ss + row0;
        const bool fin = Yf != nullptr;
        float* fline = Yf + (size_t)(row0 - fr + (fr & 7)) * DM + col0 + (fr >= 8 ? 4 : 0); const int dlt = 8 * DM + (fr >= 8 ? -4 : 4);
#pragma unroll
        for (int ai = 0; ai < 2; ++ai) {
            u32x4 xw[4][2];
#pragma unroll
            for (int m = 0; m < 4; ++m)
#pragma unroll
                for (int bj = 0; bj < 2; ++bj) xw[m][bj] = *(const u32x4*)(xo + (size_t)(ai * HALF + m * 16) * DM + bj * HALF);
            asm volatile("" ::: "memory");
#pragma unroll
            for (int m = 0; m < 4; ++m) { float s = 0.f; const size_t roff = (size_t)(ai * HALF + m * 16) * DM;
#pragma unroll
                for (int bj = 0; bj < 2; ++bj) { const u32x4 w_ = xw[m][bj];
                    const f32x4 y0 = (f32x4){bf_lo(w_.x), bf_hi(w_.x), bf_lo(w_.y), bf_hi(w_.y)} + acc[ai][bj][m][0], y1 = (f32x4){bf_lo(w_.z), bf_hi(w_.z), bf_lo(w_.w), bf_hi(w_.w)} + acc[ai][bj][m][1];
                    if (fin) { f32x4 da, db;
#pragma unroll
                        for (int j = 0; j < 4; ++j) { da[j] = __int_as_float(__builtin_amdgcn_update_dpp(__float_as_int(y0[j]), __float_as_int(y1[j]), 0x128, 0xf, 0xc, false));
                                                      db[j] = __int_as_float(__builtin_amdgcn_update_dpp(__float_as_int(y0[j]), __float_as_int(y1[j]), 0x128, 0xf, 0x3, false)); }
                        *(f32x4*)(fline + roff + bj * HALF) = da; *(f32x4*)(fline + dlt + roff + bj * HALF) = db;
                    } else {
                        s += (y0[0] * y0[0] + y0[1] * y0[1]) + (y0[2] * y0[2] + y0[3] * y0[3]) + (y1[0] * y1[0] + y1[1] * y1[1]) + (y1[2] * y1[2] + y1[3] * y1[3]);
                        u32x4 w; w.x = cvt_pk_bf16(y0[0], y0[1]); w.y = cvt_pk_bf16(y0[2], y0[3]); w.z = cvt_pk_bf16(y1[0], y1[1]); w.w = cvt_pk_bf16(y1[2], y1[3]);
                        *(u32x4*)(xo + roff + bj * HALF) = w; } }
                if (!fin) { s += shx<16>(s); s = add_x32(s); if (fq == 0) ss_add(sp + ai * HALF + m * 16, s); } }
            asm volatile("" ::: "memory"); }
    }
};
struct EpiSwiglu {
    static constexpr bool PERM = true, SS_LDS = true, HALF_OK = true;
    bf16_t* Hb; const u64* ss;
    __device__ __forceinline__ void operator()(const f32x4 (&acc)[2][2][4][2], const Unit& u, int wr, int wc, int fr, int fq, const PG8_LAS u64* ssl) const {
        const int hb = u.half > 0 ? HALF : 0;
        const int row0 = u.pm * BM + hb + wr * 64 + fr, col0 = u.pn * HALF + wc * 32 + 8 * fq;
        u64 sv[2][4];
#pragma unroll
        for (int ai = 0; ai < 2; ++ai)
#pragma unroll
            for (int m = 0; m < 4; ++m) sv[ai][m] = ssl[((hb + ai * HALF) & 255) + wr * 64 + fr + m * 16];
#pragma unroll
        for (int ai = 0; ai < 2; ++ai) { if (ai == 1 && u.half >= 0) break;
#pragma unroll
            for (int m = 0; m < 4; ++m) { bf16_t* rowp = Hb + (size_t)(row0 + ai * HALF + m * 16) * DFF + col0;
                const float rs = rstd_of(sv[ai][m]), nrs = -1.4426950408889634f * rs, rs2 = rs * rs;
                float hv[8], tv[8];
#pragma unroll
                for (int n = 0; n < 2; ++n)
#pragma unroll
                    for (int j = 0; j < 4; ++j) { const float ga = acc[ai][0][m][n][j], up = acc[ai][1][m][n][j]; tv[n * 4 + j] = nrs * ga; hv[n * 4 + j] = ga * up; }
#pragma unroll
                for (int k = 0; k < 8; ++k) tv[k] = __builtin_amdgcn_exp2f(tv[k]);
#pragma unroll
                for (int k = 0; k < 8; ++k) tv[k] = 1.0f + tv[k];
#pragma unroll
                for (int k = 0; k < 8; ++k) tv[k] = __builtin_amdgcn_rcpf(tv[k]);
#pragma unroll
                for (int k = 0; k < 8; ++k) hv[k] = hv[k] * (tv[k] * rs2);
                u32x4 w; w.x = cvt_pk_bf16(hv[0], hv[1]); w.y = cvt_pk_bf16(hv[2], hv[3]); w.z = cvt_pk_bf16(hv[4], hv[5]); w.w = cvt_pk_bf16(hv[6], hv[7]);
                *(u32x4*)rowp = w; } }
    }
};
struct EpiQKV {
    static constexpr bool PERM = true, SS_LDS = true, HALF_OK = false;
    bf16_t* QKVb; float* out; const float* qg; const float* kg; PG8_LAS float* tab; const u64* ss;
    __device__ __forceinline__ void operator()(const f32x4 (&acc)[2][2][4][2], const Unit& u, int wr, int wc, int fr, int fq, const PG8_LAS u64* ssl) const {
        const int sect = u.pn >> 3;
        const int row0 = u.pm * BM + wr * 64 + fr, colt = (u.pn & 7) * BM + wc * 32 + 8 * fq;
        const bool prompt = u.pm < MP / BM;
        if (sect < 2) {
#pragma unroll
            for (int ai = 0; ai < 2; ++ai)
#pragma unroll
                for (int m = 0; m < 4; ++m)
#pragma unroll
                    for (int bj = 0; bj < 2; ++bj) { const f32x4 a = acc[ai][bj][m][0], b = acc[ai][bj][m][1];
                        float s = (a[0] * a[0] + a[1] * a[1]) + (a[2] * a[2] + a[3] * a[3]) + (b[0] * b[0] + b[1] * b[1]) + (b[2] * b[2] + b[3] * b[3]);
                        s += shx<16>(s); s = add_x32(s);
                        if (fq == 0) tab[(((wr * 128 + ai * 64 + m * 16 + fr) * 2 + bj) << 2) + wc] = s; }
        }
        asm volatile("s_waitcnt lgkmcnt(0)" ::: "memory"); __builtin_amdgcn_s_barrier(); asm volatile("" ::: "memory");
        const int gcol = wc * 32 + 8 * fq;
        const float* gp = sect == 0 ? qg : kg;
        f32x4 g0 = *(const f32x4*)(gp + gcol), g1 = *(const f32x4*)(gp + gcol + 4);
        u64 sv[2][4];
#pragma unroll
        for (int ai = 0; ai < 2; ++ai)
#pragma unroll
            for (int m = 0; m < 4; ++m) sv[ai][m] = ssl[wr * 64 + fr + ai * HALF + m * 16];
        asm volatile("" : "+v"(g0), "+v"(g1));
        const float gs = sect == 0 ? QSCALE : 1.0f; g0 = g0 * gs; g1 = g1 * gs;
        bf16_t* bbase = QKVb + (size_t)sect * ((WS_K - WS_Q) / 2) + (size_t)row0 * DM + colt;
        const size_t fo = prompt ? (sect == 1 ? O_KP : O_VP) : ((sect == 1 ? O_KS : O_VS) - (size_t)MP * DM);
        float* fbase = out + fo + (size_t)row0 * DM + colt;
        const PG8_LAS float* trow = tab + ((wr * 128 + fr) << 3);
        float* fline = fbase - (size_t)fr * DM + (size_t)(fr & 7) * DM + (fr >= 8 ? 4 : 0);
        const int dlt = 8 * DM + (fr >= 8 ? -4 : 4);
#pragma unroll
        for (int ai = 0; ai < 2; ++ai)
#pragma unroll
            for (int m = 0; m < 4; ++m) { const size_t roff = (size_t)(ai * HALF + m * 16) * DM; const float rin = rstd_of(sv[ai][m]);
#pragma unroll
                for (int bj = 0; bj < 2; ++bj) { f32x4 v0 = acc[ai][bj][m][0], v1 = acc[ai][bj][m][1];
                    if (sect < 2) { const f32x4 t = *(const PG8_LAS f32x4*)(trow + (((ai * 64 + m * 16) * 2 + bj) << 2));
                        const float r = rin * __builtin_amdgcn_rsqf(rin * rin * ((t[0] + t[1]) + (t[2] + t[3])) * (1.0f / 128.0f) + EPS); v0 = v0 * r * g0; v1 = v1 * r * g1; }
                    else { v0 = v0 * rin; v1 = v1 * rin; }
                    if (sect > 0) {
                        f32x4 da, db;
#pragma unroll
                        for (int j = 0; j < 4; ++j) { da[j] = __int_as_float(__builtin_amdgcn_update_dpp(__float_as_int(v0[j]), __float_as_int(v1[j]), 0x128, 0xf, 0xc, false));
                                                      db[j] = __int_as_float(__builtin_amdgcn_update_dpp(__float_as_int(v0[j]), __float_as_int(v1[j]), 0x128, 0xf, 0x3, false)); }
                        *(f32x4*)(fline + roff + bj * HALF) = da; *(f32x4*)(fline + dlt + roff + bj * HALF) = db; }
                    u32x4 w; w.x = cvt_pk_bf16(v0[0], v0[1]); w.y = cvt_pk_bf16(v0[2], v0[3]); w.z = cvt_pk_bf16(v1[0], v1[1]); w.w = cvt_pk_bf16(v1[2], v1[3]);
                    *(u32x4*)(bbase + roff + bj * HALF) = w; }
                asm volatile("" ::: "memory"); }
    }
};
}

namespace att {
constexpr int SHM_V = 64 * 128 * 2, SHM_K = 64 * 128 * 2, TILE_B = SHM_K + 2 * SHM_V;
constexpr int LDK = DM;
#define KSWZ(row, colB) ((row) * 256 + ((colB) ^ (((row) & 7) << 4)))
#define SBAR() __builtin_amdgcn_sched_barrier(0)
__device__ __forceinline__ int crow(int r, int hi) { return (r & 3) + 8 * (r >> 2) + 4 * hi; }
__device__ __forceinline__ int v_rd_base(int lane) { return ((lane & 3) << 3) | (((lane >> 2) & 3) << 6) | (((lane >> 4) & 1) << 5) | (((lane >> 5) & 1) << 8); }
constexpr int v_rd_off(int d0, int ks, int half) { return d0 * 512 + ks * 4096 + half * 2048; }
template <int OFF> __device__ __forceinline__ s16x4 tr_read(int vb) {
    s16x4 r; asm volatile("ds_read_b64_tr_b16 %0, %1 offset:%2" : "=&v"(r) : "v"(vb), "i"(OFF) : "memory"); return r;
}
__device__ __forceinline__ float vadd_s(float s, float v) { float d; asm("v_add_f32 %0, %1, %2" : "=v"(d) : "s"(s), "v"(v)); return d; }
__device__ __forceinline__ float vfma_abs(float x, float a, float c) { float d; asm("v_fma_f32 %0, |%1|, %2, %3" : "=v"(d) : "v"(x), "v"(a), "s"(c)); return d; }
__device__ __forceinline__ void bias_linear16(f32x16& p, float base, float s1, float s2, float s3, float s8) {
    float b = base;
#pragma unroll
    for (int k = 0; k < 4; ++k) { p[4 * k] = b; p[4 * k + 1] = vadd_s(s1, b); p[4 * k + 2] = vadd_s(s2, b); p[4 * k + 3] = vadd_s(s3, b); b = vadd_s(s8, b); }
}
__device__ __forceinline__ void bias_diag16(f32x16& p, float dq, float nslope, float nM2, float m8) {
    float t = dq;
#pragma unroll
    for (int k = 0; k < 4; ++k) { const float t1 = t - 1.0f, t2 = t - 2.0f, t3 = t1 - 2.0f;
        p[4 * k] = vfma_abs(t, nslope, nM2); p[4 * k + 1] = vfma_abs(t1, nslope, nM2); p[4 * k + 2] = vfma_abs(t2, nslope, nM2); p[4 * k + 3] = vfma_abs(t3, nslope, nM2); t = vadd_s(m8, t); }
}
template <int OFF> __device__ __forceinline__ bf16x8 lds_rd128(int addr) { bf16x8 r; asm volatile("ds_read_b128 %0, %1 offset:%2" : "=&v"(r) : "v"(addr), "i"(OFF) : "memory"); return r; }
#define LGKM(n) asm volatile("s_waitcnt lgkmcnt(" #n ")" ::: "memory")
__device__ __forceinline__ bf16x8 vfrag(s16x4 l, s16x4 h) { return (bf16x8){l[0], l[1], l[2], l[3], h[0], h[1], h[2], h[3]}; }
__device__ __forceinline__ void tile_body3(f32x16& p, f32x16* o, float& l_acc, const bf16x8* qr, int ka0, int ka1, int ka2, int ka3, int vb, float bias1  ,
                                           bool diag, float dq, float nslope, float nM2, float m8, float s1, float s2, float s3, float s8) {
#define KRD(half, d0) (((d0) & 3) == 0 ? lds_rd128<((d0) >> 2) * 128 + (half) * 8192>(ka0) : ((d0) & 3) == 1 ? lds_rd128<((d0) >> 2) * 128 + (half) * 8192>(ka1) : ((d0) & 3) == 2 ? lds_rd128<((d0) >> 2) * 128 + (half) * 8192>(ka2) : lds_rd128<((d0) >> 2) * 128 + (half) * 8192>(ka3))
#define VOFF(ks, d0, hl) (((d0) >> 2) * 16384 + v_rd_off((d0) & 3, ks, hl))
#define VRD(L_, H_, ks, d0) do { L_ = tr_read<VOFF(ks, d0, 0)>(vb); H_ = tr_read<VOFF(ks, d0, 1)>(vb); } while (0)
#define EXP1(P, S, i) do { P[i] = __builtin_amdgcn_exp2f(P[i]); S += P[i]; } while (0)
#define PK4(P, BASE, OUT) do { unsigned a0_ = cvt_pk_bf16(P[BASE + 0], P[BASE + 1]), a1_ = cvt_pk_bf16(P[BASE + 2], P[BASE + 3]);   \
    unsigned b0_ = cvt_pk_bf16(P[BASE + 4], P[BASE + 5]), b1_ = cvt_pk_bf16(P[BASE + 6], P[BASE + 7]);                              \
    auto r0_ = __builtin_amdgcn_permlane32_swap(a0_, b0_, false, false); auto r1_ = __builtin_amdgcn_permlane32_swap(a1_, b1_, false, false); \
    u32x4 w_ = {r0_[0], r1_[0], r0_[1], r1_[1]}; OUT = *reinterpret_cast<bf16x8*>(&w_); } while (0)
    bf16x8 k0, k1; s16x4 vl0, vh0, vl1, vh1; bf16x8 paX, paY; float ps = 0.f;
    k0 = KRD(0, 0);
    k1 = KRD(0, 1); LGKM(1); SBAR(); p = __builtin_amdgcn_mfma_f32_32x32x16_bf16(k0, qr[0], p, 0, 0, 0); SBAR();
    k0 = KRD(0, 2); LGKM(1); SBAR(); p = __builtin_amdgcn_mfma_f32_32x32x16_bf16(k1, qr[1], p, 0, 0, 0); SBAR();
    k1 = KRD(0, 3); LGKM(1); SBAR(); p = __builtin_amdgcn_mfma_f32_32x32x16_bf16(k0, qr[2], p, 0, 0, 0); SBAR();
    k0 = KRD(0, 4); LGKM(1); SBAR(); p = __builtin_amdgcn_mfma_f32_32x32x16_bf16(k1, qr[3], p, 0, 0, 0); SBAR();
    k1 = KRD(0, 5); LGKM(1); SBAR(); p = __builtin_amdgcn_mfma_f32_32x32x16_bf16(k0, qr[4], p, 0, 0, 0); SBAR();
    k0 = KRD(0, 6); LGKM(1); SBAR(); p = __builtin_amdgcn_mfma_f32_32x32x16_bf16(k1, qr[5], p, 0, 0, 0); SBAR();
    k1 = KRD(0, 7); LGKM(1); SBAR(); p = __builtin_amdgcn_mfma_f32_32x32x16_bf16(k0, qr[6], p, 0, 0, 0); SBAR();
    VRD(vl0, vh0, 0, 0); LGKM(2); SBAR(); p = __builtin_amdgcn_mfma_f32_32x32x16_bf16(k1, qr[7], p, 0, 0, 0); SBAR();
    EXP1(p, ps, 0); EXP1(p, ps, 1); EXP1(p, ps, 2); EXP1(p, ps, 3); EXP1(p, ps, 4); EXP1(p, ps, 5); EXP1(p, ps, 6); EXP1(p, ps, 7); PK4(p, 0, paX); SBAR();
    VRD(vl1, vh1, 0, 1); LGKM(2); SBAR(); o[0] = __builtin_amdgcn_mfma_f32_32x32x16_bf16(paX, vfrag(vl0, vh0), o[0], 0, 0, 0); EXP1(p, ps, 8); SBAR();
    VRD(vl0, vh0, 0, 2); LGKM(2); SBAR(); o[1] = __builtin_amdgcn_mfma_f32_32x32x16_bf16(paX, vfrag(vl1, vh1), o[1], 0, 0, 0); EXP1(p, ps, 9); SBAR();
    VRD(vl1, vh1, 0, 3); LGKM(2); SBAR(); o[2] = __builtin_amdgcn_mfma_f32_32x32x16_bf16(paX, vfrag(vl0, vh0), o[2], 0, 0, 0); EXP1(p, ps, 10); SBAR();
    VRD(vl0, vh0, 0, 4); LGKM(2); SBAR(); o[3] = __builtin_amdgcn_mfma_f32_32x32x16_bf16(paX, vfrag(vl1, vh1), o[3], 0, 0, 0); EXP1(p, ps, 11); SBAR();
    VRD(vl1, vh1, 0, 5); LGKM(2); SBAR(); o[4] = __builtin_amdgcn_mfma_f32_32x32x16_bf16(paX, vfrag(vl0, vh0), o[4], 0, 0, 0); EXP1(p, ps, 12); SBAR();
    VRD(vl0, vh0, 0, 6); LGKM(2); SBAR(); o[5] = __builtin_amdgcn_mfma_f32_32x32x16_bf16(paX, vfrag(vl1, vh1), o[5], 0, 0, 0); EXP1(p, ps, 13); SBAR();
    VRD(vl1, vh1, 0, 7); LGKM(2); SBAR(); o[6] = __builtin_amdgcn_mfma_f32_32x32x16_bf16(paX, vfrag(vl0, vh0), o[6], 0, 0, 0); EXP1(p, ps, 14); SBAR();
    VRD(vl0, vh0, 1, 0); LGKM(2); SBAR(); o[7] = __builtin_amdgcn_mfma_f32_32x32x16_bf16(paX, vfrag(vl1, vh1), o[7], 0, 0, 0); EXP1(p, ps, 15); SBAR();
    PK4(p, 8, paY); SBAR();
    VRD(vl1, vh1, 1, 1); LGKM(2); SBAR(); o[0] = __builtin_amdgcn_mfma_f32_32x32x16_bf16(paY, vfrag(vl0, vh0), o[0], 0, 0, 0); SBAR();
    VRD(vl0, vh0, 1, 2); LGKM(2); SBAR(); o[1] = __builtin_amdgcn_mfma_f32_32x32x16_bf16(paY, vfrag(vl1, vh1), o[1], 0, 0, 0); SBAR();
    VRD(vl1, vh1, 1, 3); LGKM(2); SBAR(); o[2] = __builtin_amdgcn_mfma_f32_32x32x16_bf16(paY, vfrag(vl0, vh0), o[2], 0, 0, 0); SBAR();
    VRD(vl0, vh0, 1, 4); LGKM(2); SBAR(); o[3] = __builtin_amdgcn_mfma_f32_32x32x16_bf16(paY, vfrag(vl1, vh1), o[3], 0, 0, 0); SBAR();
    VRD(vl1, vh1, 1, 5); LGKM(2); SBAR(); o[4] = __builtin_amdgcn_mfma_f32_32x32x16_bf16(paY, vfrag(vl0, vh0), o[4], 0, 0, 0); SBAR();
    VRD(vl0, vh0, 1, 6); LGKM(2); SBAR(); o[5] = __builtin_amdgcn_mfma_f32_32x32x16_bf16(paY, vfrag(vl1, vh1), o[5], 0, 0, 0); SBAR();
    VRD(vl1, vh1, 1, 7); LGKM(2); SBAR(); o[6] = __builtin_amdgcn_mfma_f32_32x32x16_bf16(paY, vfrag(vl0, vh0), o[6], 0, 0, 0); SBAR();
    k0 = KRD(1, 0); LGKM(1); SBAR(); o[7] = __builtin_amdgcn_mfma_f32_32x32x16_bf16(paY, vfrag(vl1, vh1), o[7], 0, 0, 0); SBAR();
    if (diag) bias_diag16(p, dq - 32.0f, nslope, nM2, m8); else bias_linear16(p, bias1, s1, s2, s3, s8);
    SBAR();
    k1 = KRD(1, 1); LGKM(1); SBAR(); p = __builtin_amdgcn_mfma_f32_32x32x16_bf16(k0, qr[0], p, 0, 0, 0); SBAR();
    k0 = KRD(1, 2); LGKM(1); SBAR(); p = __builtin_amdgcn_mfma_f32_32x32x16_bf16(k1, qr[1], p, 0, 0, 0); SBAR();
    k1 = KRD(1, 3); LGKM(1); SBAR(); p = __builtin_amdgcn_mfma_f32_32x32x16_bf16(k0, qr[2], p, 0, 0, 0); SBAR();
    k0 = KRD(1, 4); LGKM(1); SBAR(); p = __builtin_amdgcn_mfma_f32_32x32x16_bf16(k1, qr[3], p, 0, 0, 0); SBAR();
    k1 = KRD(1, 5); LGKM(1); SBAR(); p = __builtin_amdgcn_mfma_f32_32x32x16_bf16(k0, qr[4], p, 0, 0, 0); SBAR();
    k0 = KRD(1, 6); LGKM(1); SBAR(); p = __builtin_amdgcn_mfma_f32_32x32x16_bf16(k1, qr[5], p, 0, 0, 0); SBAR();
    k1 = KRD(1, 7); LGKM(1); SBAR(); p = __builtin_amdgcn_mfma_f32_32x32x16_bf16(k0, qr[6], p, 0, 0, 0); SBAR();
    VRD(vl0, vh0, 2, 0); LGKM(2); SBAR(); p = __builtin_amdgcn_mfma_f32_32x32x16_bf16(k1, qr[7], p, 0, 0, 0); SBAR();
    EXP1(p, ps, 0); EXP1(p, ps, 1); EXP1(p, ps, 2); EXP1(p, ps, 3); EXP1(p, ps, 4); EXP1(p, ps, 5); EXP1(p, ps, 6); EXP1(p, ps, 7); PK4(p, 0, paX); SBAR();
    VRD(vl1, vh1, 2, 1); LGKM(2); SBAR(); o[0] = __builtin_amdgcn_mfma_f32_32x32x16_bf16(paX, vfrag(vl0, vh0), o[0], 0, 0, 0); EXP1(p, ps, 8); SBAR();
    VRD(vl0, vh0, 2, 2); LGKM(2); SBAR(); o[1] = __builtin_amdgcn_mfma_f32_32x32x16_bf16(paX, vfrag(vl1, vh1), o[1], 0, 0, 0); EXP1(p, ps, 9); SBAR();
    VRD(vl1, vh1, 2, 3); LGKM(2); SBAR(); o[2] = __builtin_amdgcn_mfma_f32_32x32x16_bf16(paX, vfrag(vl0, vh0), o[2], 0, 0, 0); EXP1(p, ps, 10); SBAR();
    VRD(vl0, vh0, 2, 4); LGKM(2); SBAR(); o[3] = __builtin_amdgcn_mfma_f32_32x32x16_bf16(paX, vfrag(vl1, vh1), o[3], 0, 0, 0); EXP1(p, ps, 11); SBAR();
    VRD(vl1, vh1, 2, 5); LGKM(2); SBAR(); o[4] = __builtin_amdgcn_mfma_f32_32x32x16_bf16(paX, vfrag(vl0, vh0), o[4], 0, 0, 0); EXP1(p, ps, 12); SBAR();
    VRD(vl0, vh0, 2, 6); LGKM(2); SBAR(); o[5] = __builtin_amdgcn_mfma_f32_32x32x16_bf16(paX, vfrag(vl1, vh1), o[5], 0, 0, 0); EXP1(p, ps, 13); SBAR();
    VRD(vl1, vh1, 2, 7); LGKM(2); SBAR(); o[6] = __builtin_amdgcn_mfma_f32_32x32x16_bf16(paX, vfrag(vl0, vh0), o[6], 0, 0, 0); EXP1(p, ps, 14); SBAR();
    VRD(vl0, vh0, 3, 0); LGKM(2); SBAR(); o[7] = __builtin_amdgcn_mfma_f32_32x32x16_bf16(paX, vfrag(vl1, vh1), o[7], 0, 0, 0); EXP1(p, ps, 15); SBAR();
    PK4(p, 8, paY); SBAR();
    VRD(vl1, vh1, 3, 1); LGKM(2); SBAR(); o[0] = __builtin_amdgcn_mfma_f32_32x32x16_bf16(paY, vfrag(vl0, vh0), o[0], 0, 0, 0); SBAR();
    VRD(vl0, vh0, 3, 2); LGKM(2); SBAR(); o[1] = __builtin_amdgcn_mfma_f32_32x32x16_bf16(paY, vfrag(vl1, vh1), o[1], 0, 0, 0); SBAR();
    VRD(vl1, vh1, 3, 3); LGKM(2); SBAR(); o[2] = __builtin_amdgcn_mfma_f32_32x32x16_bf16(paY, vfrag(vl0, vh0), o[2], 0, 0, 0); SBAR();
    VRD(vl0, vh0, 3, 4); LGKM(2); SBAR(); o[3] = __builtin_amdgcn_mfma_f32_32x32x16_bf16(paY, vfrag(vl1, vh1), o[3], 0, 0, 0); SBAR();
    VRD(vl1, vh1, 3, 5); LGKM(2); SBAR(); o[4] = __builtin_amdgcn_mfma_f32_32x32x16_bf16(paY, vfrag(vl0, vh0), o[4], 0, 0, 0); SBAR();
    VRD(vl0, vh0, 3, 6); LGKM(2); SBAR(); o[5] = __builtin_amdgcn_mfma_f32_32x32x16_bf16(paY, vfrag(vl1, vh1), o[5], 0, 0, 0); SBAR();
    VRD(vl1, vh1, 3, 7); LGKM(2); SBAR(); o[6] = __builtin_amdgcn_mfma_f32_32x32x16_bf16(paY, vfrag(vl0, vh0), o[6], 0, 0, 0); SBAR();
    LGKM(0); SBAR(); o[7] = __builtin_amdgcn_mfma_f32_32x32x16_bf16(paY, vfrag(vl1, vh1), o[7], 0, 0, 0); SBAR();
    l_acc += ps;
#undef KRD
#undef VOFF
#undef VRD
#undef EXP1
#undef PK4
}
#undef LGKM
__device__ __forceinline__ int att_tlo(int P0, int h) {
    const float wd = 150.0f / (exp2f(-(float)(h + 1)) * 1.4426950408889634f);
    const float x = ((float)P0 - 63.0f - wd) * (1.0f / 64.0f);
    return x > 0.f ? (int)x : 0;
}
constexpr int ITEMS_PER_Q = 160;
__device__ __forceinline__ void att_item(int q, int j, bool& prompt, int& b, int& h, int& qb) {
    prompt = j < 128;
    if (prompt) { const int hs = j >> 5; b = q >> 1; h = (((q & 1) ? 0x3416 : 0x2507) >> (4 * hs)) & 15; qb = j & 31; }
    else { const int s_ = j - 128; b = 4 * q + (s_ >> 3); h = s_ & 7; qb = 0; }
}
__device__ __forceinline__ int att_cost(int q, int j) {
    bool prompt; int b, h, qb; att_item(q, j, prompt, b, h, qb);
    return prompt ? (4 * qb + 4 - att_tlo(qb * 256, h)) : 22 + ((j - 128) * 106) / 31;
}
struct UnitDesc {
    const bf16_t* Q;
    const bf16_t* K0; const bf16_t* V0; int nt0;
    const bf16_t* K1; const bf16_t* V1;
    bf16_t* O;
    int NT;
    int t_lo;
    int ntw;
    int qbase;
    float slope2;
    bool nodma;
};
__device__ __forceinline__ void attn_unit(const UnitDesc& U, const volatile LAS float* lamp, float M2, const float* subln, float* scr, char* lds, int wv) {
    int tid = (wv << 6) | lane_id_v(); asm volatile("" : "+v"(tid));
    const int wid = __builtin_amdgcn_readfirstlane(tid >> 6), lane = tid & 63, r32 = lane & 31, hi = lane >> 5;
    LAS unsigned char* ldsl = (LAS unsigned char*)lds;
    const int kl0 = (int)(uintptr_t)lds, vb0 = (int)(uintptr_t)lds + SHM_K + v_rd_base(lane);
    unsigned kof0, kof1, vof0, vof1;
    { const int p0_ = wid * 1024 + lane * 16, p1_ = p0_ + 8192;
      { const int row = p0_ >> 8, x = p0_ & 255; kof0 = (unsigned)(row * LDK * 2 + (x ^ ((row & 7) << 4))); }
      { const int row = p1_ >> 8, x = p1_ & 255; kof1 = (unsigned)(row * LDK * 2 + (x ^ ((row & 7) << 4))); }
      { const int st = p0_ >> 9, y = p0_ & 511, kk = (st >> 2) * 8 + (y >> 6), k = (kk & ~0xC) | ((kk & 4) << 1) | ((kk & 8) >> 1), c = (st & 3) * 32 + ((y & 63) >> 1); vof0 = (unsigned)(k * LDK * 2 + c * 2); }
      { const int st = p1_ >> 9, y = p1_ & 511, kk = (st >> 2) * 8 + (y >> 6), k = (kk & ~0xC) | ((kk & 4) << 1) | ((kk & 8) >> 1), c = (st & 3) * 32 + ((y & 63) >> 1); vof1 = (unsigned)(k * LDK * 2 + c * 2); } }
    const int NT = U.NT, ntw = U.ntw, nt0 = U.nt0, t_lo = U.t_lo;
    int tlo_w;
    { const float x_ = ((float)U.qbase - 63.0f - 150.0f / U.slope2) * (1.0f / 64.0f); tlo_w = __builtin_amdgcn_readfirstlane(x_ > 0.f ? (int)x_ : 0); }
    const float slope2 = U.slope2, s2x = 2.f * slope2, s3x = 3.f * slope2, s8x = 8.f * slope2, nM2 = -M2;
    float nslope = -slope2; asm volatile("" : "+v"(nslope));
    float m8 = -8.0f; asm volatile("" : "+s"(m8));
    float l_reg = 0.f; f32x16 o[8];
#pragma unroll 1
    for (int pass = 0; pass < 2; ++pass) {
        const int c = pass;
        float qp4; { int lp_ = lane_id_v(); qp4 = (float)(U.qbase + (lp_ & 31) - 4 * (lp_ >> 5)); }
        const bf16_t* Kh0 = U.K0 + c * HH; const bf16_t* Kh1 = U.K1 + c * HH; const bf16_t* Vh0 = U.V0; const bf16_t* Vh1 = U.V1;
        bf16x8 qr[8];
        if (ntw > 0) {
            const bf16_t* Qw = U.Q + (size_t)(wid * 32 + r32) * LDK + c * HH + hi * 8;
#pragma unroll
            for (int d0 = 0; d0 < 8; ++d0) qr[d0] = *reinterpret_cast<const bf16x8*>(Qw + d0 * 16);
#pragma unroll
            for (int d0 = 0; d0 < 8; ++d0) asm volatile("" : "+v"(qr[d0]));
        } else {
#pragma unroll
            for (int d0 = 0; d0 < 8; ++d0) qr[d0] = (bf16x8){0, 0, 0, 0, 0, 0, 0, 0};
        }
        l_reg = 0.f;
#pragma unroll
        for (int d0 = 0; d0 < 8; ++d0) o[d0] = f32x16{};
#define TKP(t) (((t) < nt0) ? (Kh0 + (size_t)(t) * 64 * LDK) : (Kh1 + (size_t)((t) - nt0) * 64 * LDK))
#define TVP(t) (((t) < nt0) ? (Vh0 + (size_t)(t) * 64 * LDK) : (Vh1 + (size_t)((t) - nt0) * 64 * LDK))
#define DMA_TILE(t_, bsel_) do { const int tt_ = (t_) < NT ? (t_) : NT - 1; const char* kp_ = (const char*)TKP(tt_); const char* vp_ = (const char*)TVP(tt_); \
    LAS unsigned char* bb_ = ldsl + (bsel_) * TILE_B + wid * 1024; \
    __builtin_amdgcn_global_load_lds((const unsigned*)(kp_ + kof0), (LAS unsigned*)(bb_), 16, 0, 0); \
    __builtin_amdgcn_global_load_lds((const unsigned*)(kp_ + kof1), (LAS unsigned*)(bb_ + 8192), 16, 0, 0); \
    __builtin_amdgcn_global_load_lds((const unsigned*)(vp_ + vof0), (LAS unsigned*)(bb_ + SHM_K), 16, 0, 0); \
    __builtin_amdgcn_global_load_lds((const unsigned*)(vp_ + vof1), (LAS unsigned*)(bb_ + SHM_K + 8192), 16, 0, 0); \
    __builtin_amdgcn_global_load_lds((const unsigned*)(vp_ + vof0 + 256), (LAS unsigned*)(bb_ + SHM_K + SHM_V), 16, 0, 0); \
    __builtin_amdgcn_global_load_lds((const unsigned*)(vp_ + vof1 + 256), (LAS unsigned*)(bb_ + SHM_K + SHM_V + 8192), 16, 0, 0); } while (0)
#define BARX() do { asm volatile("" ::: "memory"); __builtin_amdgcn_s_barrier(); asm volatile("" ::: "memory"); } while (0)
        f32x16 pA0;
        asm volatile("s_waitcnt vmcnt(0) lgkmcnt(0)" ::: "memory"); BARX();
        if (!U.nodma) { DMA_TILE(t_lo, 0); DMA_TILE(t_lo + 1, 1); }
        asm volatile("s_waitcnt vmcnt(6)" ::: "memory"); BARX();
        int bsel = 0;
#pragma unroll 1
        for (int t = t_lo; t < NT; ++t) {
            if (!U.nodma) { const int bn = bsel == 0 ? 2 : bsel - 1; DMA_TILE(t + 2, bn); }
            SBAR();
            if (t >= tlo_w && t < ntw) {
                const float dq_ = qp4 - (float)(64 * t); const bool diag_ = (t == ntw - 1); const float base0_ = fmaf(nslope, dq_, nM2);
                if (diag_) bias_diag16(pA0, dq_, nslope, nM2, m8); else bias_linear16(pA0, base0_, slope2, s2x, s3x, s8x);
                { const int kb_ = kl0 + bsel * TILE_B;
                  tile_body3(pA0, o, l_reg, qr, kb_ + KSWZ(r32, (0 * 16 + hi * 8) * 2), kb_ + KSWZ(r32, (1 * 16 + hi * 8) * 2), kb_ + KSWZ(r32, (2 * 16 + hi * 8) * 2), kb_ + KSWZ(r32, (3 * 16 + hi * 8) * 2), vb0 + bsel * TILE_B,
                             fmaf(32.0f, slope2, base0_), diag_, dq_, nslope, nM2, m8, slope2, s2x, s3x, s8x); }
            }
            SBAR();
            asm volatile("s_waitcnt vmcnt(6) lgkmcnt(0)" ::: "memory"); BARX();
            if (wid >= 4) __builtin_amdgcn_s_sleep(5);
            bsel = bsel == 2 ? 0 : bsel + 1;
        }
        asm volatile("s_waitcnt vmcnt(0)" ::: "memory");
#undef TKP
#undef TVP
#undef DMA_TILE
#undef BARX
        { auto rr = __builtin_amdgcn_permlane32_swap(__float_as_uint(l_reg), __float_as_uint(l_reg), false, false); l_reg = __uint_as_float(rr[0]) + __uint_as_float(rr[1]); }
        if (ntw > 0 && pass == 0) {
            int le_ = lane_id_v(); const int r32 = le_ & 31, hi = le_ >> 5;
            float* li_l = (float*)(lds + LDSX_OFF) + wid * 64;
            float* myscr = scr + ((size_t)(blockIdx.x * 8 + wid) * 64 + le_) * 128;
            if (hi == 0) li_l[r32] = l_reg;
            asm volatile("s_waitcnt lgkmcnt(0)" ::: "memory");
#pragma unroll
            for (int d0 = 0; d0 < 8; ++d0)
#pragma unroll
                for (int k = 0; k < 4; ++k) { f32x4 t;
#pragma unroll
                    for (int j = 0; j < 4; ++j) t[j] = o[d0][4 * k + j] * __builtin_amdgcn_rcpf(li_l[crow(4 * k + j, hi)]);
                    *(f32x4*)(myscr + d0 * 16 + 4 * k) = t; }
            asm volatile("s_waitcnt lgkmcnt(0)" ::: "memory");
        }
    }
    asm volatile("" ::: "memory"); __builtin_amdgcn_s_barrier(); asm volatile("" ::: "memory");
    if (ntw > 0) {
        int le_ = lane_id_v(); const int r32 = le_ & 31, hi = le_ >> 5;
        const float lam = *lamp;
        float* li_l = (float*)(lds + LDSX_OFF) + wid * 64;
        float* myscr = scr + ((size_t)(blockIdx.x * 8 + wid) * 64 + le_) * 128;
        if (hi == 0) li_l[r32] = l_reg;
        asm volatile("s_waitcnt lgkmcnt(0)" ::: "memory");
        float ss[16];
#pragma unroll
        for (int r = 0; r < 16; ++r) { ss[r] = 0.f; const float rl = lam * __builtin_amdgcn_rcpf(li_l[crow(r, hi)]);
#pragma unroll
            for (int d0 = 0; d0 < 8; ++d0) o[d0][r] *= rl; }
#pragma unroll
        for (int d0 = 0; d0 < 8; ++d0)
#pragma unroll
            for (int k = 0; k < 4; ++k) { const f32x4 t1 = *(const f32x4*)(myscr + d0 * 16 + 4 * k);
#pragma unroll
                for (int j = 0; j < 4; ++j) { const float t = t1[j] - o[d0][4 * k + j]; o[d0][4 * k + j] = t; ss[4 * k + j] += t * t; } }
#pragma unroll
        for (int r = 0; r < 16; ++r) {
            ss[r] += shx<1>(ss[r]); ss[r] += shx<2>(ss[r]); ss[r] += shx<4>(ss[r]); ss[r] += shx<8>(ss[r]); ss[r] += shx<16>(ss[r]);
            ss[r] = (1.0f - LAM_INIT) * __builtin_amdgcn_rsqf(ss[r] * (1.0f / 256.0f) + EPS); }
        LAS unsigned char* ob = (LAS unsigned char*)lds + wid * 16896;
        const int wofs = (4 * hi) * 528 + r32 * 2;
#pragma unroll
        for (int d0 = 0; d0 < 8; ++d0) { const float g = subln[d0 * 32 + r32];
#pragma unroll
            for (int r = 0; r < 16; ++r) {
                const float v = o[d0][r] * ss[r] * g; const float vn = shx<1>(v);
                if ((r32 & 1) == 0) *(LAS unsigned*)(ob + wofs + ((r & 3) + 8 * (r >> 2)) * 528 + d0 * 64) = cvt_pk_bf16(v, vn); }
            asm volatile("" ::: "memory"); }
        asm volatile("s_waitcnt lgkmcnt(0)" ::: "memory");
        bf16_t* Ow = U.O + (size_t)(wid * 32 + hi) * LDK + r32 * 8;
#pragma unroll
        for (int i = 0; i < 16; ++i) { const u32x4 w_ = *(const LAS u32x4*)(ob + (2 * i + hi) * 528 + r32 * 16); *(u32x4*)(Ow + (size_t)(2 * i) * LDK) = w_; }
    }
}

__device__ __forceinline__ void loader_unit(const float* ckf, const float* cvf  , bf16_t* cvb  , const bf16_t* K1, const bf16_t* V1  , int t_lo, char* lds, int wv) {
    int tid = (wv << 6) | lane_id_v(); asm volatile("" : "+v"(tid));
    const int wid = __builtin_amdgcn_readfirstlane(tid >> 6), lane = tid & 63, lw = wid - 2;
    constexpr int NT = PAST / 64 + 1, NC = PAST / 64;
    LAS unsigned char* ldsl = (LAS unsigned char*)lds;
    unsigned soff[8];
#pragma unroll
    for (int i = 0; i < 8; ++i) { const int g = lw + 6 * i;
        if (g < 16) { const int p_ = g * 1024 + lane * 16, row = p_ >> 8, x = p_ & 255; soff[i] = (unsigned)(row * LDK * 2 + (x ^ ((row & 7) << 4))); }
        else { const int gv = g - 16, hv = gv >> 4, p_ = (gv & 15) * 1024 + lane * 16, st = p_ >> 9, y = p_ & 511, kk = (st >> 2) * 8 + (y >> 6), k = (kk & ~0xC) | ((kk & 4) << 1) | ((kk & 8) >> 1), cc = (st & 3) * 32 + ((y & 63) >> 1);
            soff[i] = (unsigned)(k * LDK * 2 + cc * 2 + hv * 256); } }
    const int lane16 = lane * 16;
#define DOF(i) (((lw + 6 * (i)) < 16 ? (lw + 6 * (i)) * 1024 : SHM_K + (((lw + 6 * (i)) - 16) >> 4) * SHM_V + (((lw + 6 * (i)) - 16) & 15) * 1024) + lane16)
    f32x4 ra[8], rb[8], rc[8], rd[8];
#define BARX() do { asm volatile("" ::: "memory"); __builtin_amdgcn_s_barrier(); asm volatile("" ::: "memory"); } while (0)
#define LD_TILE(t_, RA, RB) do { const int tt_ = (t_); const bool cache_ = tt_ < NC, vf32_ = cache_ && c == 0;     \
        const char* kb_ = cache_ ? (const char*)ckf + (size_t)tt_ * 64 * DM * 4 + c * HH * 4 : (const char*)K1 + c * HH * 2; \
        const char* vb_ = vf32_ ? (const char*)cvf + (size_t)tt_ * 64 * DM * 4 : (cache_ ? (const char*)cvb + (size_t)tt_ * 64 * DM * 2 : (const char*)V1); \
        _Pragma("unroll") for (int i = 0; i < 8; ++i) { const bool isk_ = (lw + 6 * i) < 16, f32_ = isk_ ? cache_ : vf32_; \
            const char* sp_ = (isk_ ? kb_ : vb_) + (f32_ ? 2u * soff[i] : soff[i]); RA[i] = *(const f32x4*)sp_; RB[i] = *(const f32x4*)(sp_ + 16); } } while (0)
#define ST_TILE(buf_, t_, RA, RB) do { const int tt_ = (t_); const bool cache_ = tt_ < NC, vf32_ = cache_ && c == 0; \
        _Pragma("unroll") for (int i = 0; i < 8; ++i) { const bool isk_ = (lw + 6 * i) < 16, f32_ = isk_ ? cache_ : vf32_; u32x4 w_; \
        if (f32_) { w_.x = cvt_pk_bf16(RA[i][0], RA[i][1]); w_.y = cvt_pk_bf16(RA[i][2], RA[i][3]); w_.z = cvt_pk_bf16(RB[i][0], RB[i][1]); w_.w = cvt_pk_bf16(RB[i][2], RB[i][3]); } \
        else { w_.x = __float_as_uint(RA[i][0]); w_.y = __float_as_uint(RA[i][1]); w_.z = __float_as_uint(RA[i][2]); w_.w = __float_as_uint(RA[i][3]); } \
        *(LAS u32x4*)(ldsl + (buf_) * TILE_B + DOF(i)) = w_; \
        if (vf32_ && !isk_) *(u32x4*)((char*)cvb + (size_t)tt_ * 64 * DM * 2 + soff[i]) = w_; } } while (0)
#pragma unroll 1
    for (int c = 0; c < 2; ++c) {
        asm volatile("s_waitcnt lgkmcnt(0)" ::: "memory"); BARX();
        LD_TILE(t_lo, ra, rb); LD_TILE(t_lo + 1, rc, rd);
        ST_TILE(0, t_lo, ra, rb); LD_TILE(t_lo + 2, ra, rb);
        ST_TILE(1, t_lo + 1, rc, rd); LD_TILE(t_lo + 3, rc, rd);
        asm volatile("s_waitcnt lgkmcnt(0)" ::: "memory"); BARX();
        int bsel = 0;
#pragma unroll 1
        for (int t = t_lo; t < NT; t += 2) {
            { const int bn = bsel == 0 ? 2 : bsel - 1;
              if (t + 2 < NT) ST_TILE(bn, t + 2, ra, rb);
              if (t + 4 < NT) LD_TILE(t + 4, ra, rb);
              asm volatile("s_waitcnt lgkmcnt(0)" ::: "memory"); BARX();
              bsel = bsel == 2 ? 0 : bsel + 1; }
            if (t + 1 >= NT) break;
            { const int bn = bsel == 0 ? 2 : bsel - 1;
              if (t + 3 < NT) ST_TILE(bn, t + 3, rc, rd);
              if (t + 5 < NT) LD_TILE(t + 5, rc, rd);
              asm volatile("s_waitcnt lgkmcnt(0)" ::: "memory"); BARX();
              bsel = bsel == 2 ? 0 : bsel + 1; }
        }
    }
    BARX();
#undef DOF
#undef LD_TILE
#undef ST_TILE
#undef BARX
}
}

#define XB_TMO      128
#define XB_XCNT(j)  (256  + 64 * (j))
#define XB_XSUB(j)  (1280 + 64 * (j))
#define XB_XGEN(j)  (2304 + 64 * (j))
#define XB_TOP      3328
#define XB_TOPGEN   3392
#define XCD_BAR_WORDS 3456
#define XB_SPIN_CAP (1u << 18)
__device__ __forceinline__ unsigned xb_ld(unsigned* p)              { return __hip_atomic_load(p, __ATOMIC_RELAXED, __HIP_MEMORY_SCOPE_AGENT); }
__device__ __forceinline__ unsigned xb_add(unsigned* p, unsigned v) { return __hip_atomic_fetch_add(p, v, __ATOMIC_RELAXED, __HIP_MEMORY_SCOPE_AGENT); }
__device__ __forceinline__ unsigned xb_xcc_id() { return (unsigned)__builtin_amdgcn_s_getreg((3 << 11) | 20) & 0xFu; }
#define XB_SPIN(cond, bar) do { unsigned _sp = 0; while (cond) { __builtin_amdgcn_s_sleep(1); \
    if ((++_sp & 255u) == 0u) { if (xb_ld(&(bar)[XB_TMO])) break; if (_sp > XB_SPIN_CAP) { atomicAdd(&(bar)[XB_TMO], 1u); break; } } } } while (0)
struct XcdBarrier { unsigned* bar; unsigned x; volatile LAS unsigned* st; };
__device__ __forceinline__ XcdBarrier xcd_barrier_post(unsigned* bar, volatile LAS unsigned* st, bool t0) {
    XcdBarrier b; b.bar = bar; b.x = xb_xcc_id(); b.st = st;
    if (t0) (void)xb_add(&bar[XB_XCNT(b.x)], 1u);
    return b;
}
__device__ __forceinline__ void xcd_barrier_complete(unsigned* bar, unsigned x, unsigned& nloc, unsigned& nx) {
    const unsigned G = gridDim.x * gridDim.y * gridDim.z;
    unsigned sum, cnt, mine, sp = 0u;
    for (;;) {
        sum = 0u; cnt = 0u; mine = 0u;
#pragma unroll
        for (unsigned j = 0; j < 16; ++j) { const unsigned c = xb_ld(&bar[XB_XCNT(j)]); sum += c; cnt += (c > 0u) ? 1u : 0u; mine = (j == x) ? c : mine; }
        if (sum == G) break;
        __builtin_amdgcn_s_sleep(1);
        if ((++sp & 255u) == 0u) { if (xb_ld(&bar[XB_TMO])) break; if (sp > XB_SPIN_CAP) { atomicAdd(&bar[XB_TMO], 1u); break; } }
    }
    nloc = mine > 0u ? mine : 1u; nx = cnt > 0u ? cnt : 1u;
}
__device__ __forceinline__ void xcd_barrier(const XcdBarrier& b, bool t0  ) {
    asm volatile("s_waitcnt vmcnt(0)" ::: "memory");
    __syncthreads();
    if (t0) {
        unsigned* bar = b.bar;
        __builtin_amdgcn_s_waitcnt(0);
        unsigned nloc = b.st[0], nx = b.st[1];
        if (nloc == 0u) { xcd_barrier_complete(bar, b.x, nloc, nx); b.st[0] = nloc; b.st[1] = nx; }
        const unsigned old = xb_add(&bar[XB_XSUB(b.x)], 1u);
        const unsigned gen = old / nloc;
        if (old + 1u == (gen + 1u) * nloc) {
            __builtin_amdgcn_fence(__ATOMIC_RELEASE, "agent");
            asm volatile("s_waitcnt vmcnt(0)" ::: "memory");
            const unsigned og = xb_add(&bar[XB_TOP], 1u);
            const unsigned tg = og / nx;
            if (og + 1u == (tg + 1u) * nx) xb_add(&bar[XB_TOPGEN], 1u);
            else XB_SPIN(xb_ld(&bar[XB_TOPGEN]) == tg, bar);
            __builtin_amdgcn_fence(__ATOMIC_ACQUIRE, "agent");
            xb_add(&bar[XB_XGEN(b.x)], 1u);
            asm volatile("s_waitcnt vmcnt(0)" ::: "memory");
        } else {
            XB_SPIN(xb_ld(&bar[XB_XGEN(b.x)]) == gen, bar);
            __builtin_amdgcn_fence(__ATOMIC_ACQUIRE, "agent");
            asm volatile("s_waitcnt vmcnt(0)" ::: "memory");
        }
    }
    __syncthreads();
}

__device__ __forceinline__ void transpose_item(const float* W, int N, bf16_t* WT, int ldt, int row_off, int mode, LAS float* scr, int item, int lane, const float* gain) {
    const int nblk = N / 32, kb = item / nblk, nb = item % nblk, k0 = 64 * kb, n0 = 32 * nb;
    const int c8 = lane & 7;
    f32x4 ga = (f32x4){1.f, 1.f, 1.f, 1.f}, gb = ga;
    if (gain != nullptr) { ga = *(const f32x4*)(gain + k0 + 8 * c8); gb = *(const f32x4*)(gain + k0 + 8 * c8 + 4); }
#pragma unroll 8
    for (int i = 0; i < 32; ++i) { const int kk = 2 * i + (lane >> 5); scr[kk * 33 + (lane & 31)] = W[(size_t)(k0 + kk) * N + n0 + (lane & 31)]; }
    LDS_WAIT(); asm volatile("" ::: "memory");
    const int rbase = mode == 0 ? row_off + n0 : ((n0 >> 7) * 256 + (n0 & 127) + (mode == 2 ? 128 : 0));
#pragma unroll
    for (int j = 0; j < 4; ++j) { const int n = (lane >> 3) + 8 * j; const LAS float* s = scr + (8 * c8) * 33 + n;
        u32x4 o; o.x = cvt_pk_bf16(s[0 * 33] * ga[0], s[1 * 33] * ga[1]); o.y = cvt_pk_bf16(s[2 * 33] * ga[2], s[3 * 33] * ga[3]); o.z = cvt_pk_bf16(s[4 * 33] * gb[0], s[5 * 33] * gb[1]); o.w = cvt_pk_bf16(s[6 * 33] * gb[2], s[7 * 33] * gb[3]);
        *(u32x4*)(WT + (size_t)(rbase + n) * ldt + k0 + 8 * c8) = o; }
    LDS_WAIT(); asm volatile("" ::: "memory");
}
__device__ __forceinline__ float row_rstd(const float* xrow, int lane) {
    const f32x4* xr = (const f32x4*)xrow + lane * 2; float ss = 0.f;
#pragma unroll
    for (int j = 0; j < 4; ++j) { const f32x4 a = xr[j * 128], b = xr[j * 128 + 1];
        ss += (a[0] * a[0] + a[1] * a[1]) + (a[2] * a[2] + a[3] * a[3]) + (b[0] * b[0] + b[1] * b[1]) + (b[2] * b[2] + b[3] * b[3]); }
    ss = wave_sum(ss);
    return __builtin_amdgcn_rsqf(ss * (1.0f / DM) + EPS);
}
__device__ __forceinline__ void fix_row(bf16_t* xrow, const float* prow  , u64* ssp, float* yrow, int lane) {
    float ssq = 0.f;
#pragma unroll
    for (int j = 0; j < 4; ++j) { const u32x4 w_ = *(const u32x4*)(xrow + j * 512 + lane * 8);
        f32x4 a = (f32x4){bf_lo(w_.x), bf_hi(w_.x), bf_lo(w_.y), bf_hi(w_.y)}, b = (f32x4){bf_lo(w_.z), bf_hi(w_.z), bf_lo(w_.w), bf_hi(w_.w)};
        const f32x4* pr = (const f32x4*)prow + j * 128 + lane * 2;
#pragma unroll
        for (int q = 0; q < 4; ++q) { a += pr[(size_t)q * (MS * DM / 4)]; b += pr[(size_t)q * (MS * DM / 4) + 1]; }
        if (yrow != nullptr) { ((f32x4*)yrow)[j * 128 + lane * 2] = a; ((f32x4*)yrow)[j * 128 + lane * 2 + 1] = b; }
        else { ssq += (a[0] * a[0] + a[1] * a[1]) + (a[2] * a[2] + a[3] * a[3]) + (b[0] * b[0] + b[1] * b[1]) + (b[2] * b[2] + b[3] * b[3]);
            u32x4 w; w.x = cvt_pk_bf16(a[0], a[1]); w.y = cvt_pk_bf16(a[2], a[3]); w.z = cvt_pk_bf16(b[0], b[1]); w.w = cvt_pk_bf16(b[2], b[3]);
            *(u32x4*)(xrow + j * 512 + lane * 8) = w; } }
    if (yrow == nullptr) { ssq = wave_sum(ssq); if (lane == 0) *ssp = (u64)(ssq * SS_SCALE); }
}

struct Args { const float* in[22]; float* out; unsigned char* ws; int ph_lo, ph_hi; };
constexpr int N_PHASES = 16;

__global__ void __launch_bounds__(512, 2) mk_fwd(Args args) {
    extern __shared__ __attribute__((aligned(16))) unsigned char lds_raw[];
    LAS unsigned char* lds = (LAS unsigned char*)lds_raw;
    volatile LAS unsigned* MISC = (volatile LAS unsigned*)(lds + MISC_OFF);
#define MK_TID() ((wv << 6) | lane_id_v())
#define PHASE_TID() int tid = MK_TID(); asm volatile("" : "+v"(tid)); const int lane = tid & 63, wave = __builtin_amdgcn_readfirstlane(tid >> 6), gw = vcu * 8 + wave; (void)lane; (void)gw
    const int G = gridDim.x, bx = blockIdx.x;
    const int vcu = (G % 8 == 0) ? (bx % 8) * (G / 8) + bx / 8 : bx;
    unsigned char* ws = args.ws;
    unsigned* ctl = (unsigned*)(ws + WS_CTL);
    int wv = __builtin_amdgcn_readfirstlane((int)threadIdx.x >> 6); asm volatile("" : "+s"(wv));
    for (int u = threadIdx.x; u < (LDS_BYTES - MISC_OFF) / 4; u += 512) ((LAS unsigned*)(lds + MISC_OFF))[u] = 0u;
    __syncthreads();
    XcdBarrier bar; bar.bar = ctl + CW_BAR; bar.x = 0; bar.st = nullptr;
    if (MK_N_LAUNCHES == 1) bar = xcd_barrier_post(ctl + CW_BAR, MISC + 8, threadIdx.x == 0);
    const int lo = args.ph_lo, hi = args.ph_hi; (void)lo; (void)hi;
#ifndef PHMASK
#define PHMASK 0xFFFF
#endif
#if MK_N_LAUNCHES == 1
#define IN(k) ((PHMASK >> (k)) & 1)
#else
#define IN(k) (((PHMASK >> (k)) & 1) && lo <= (k) && (k) < hi)
#endif
#define SEAM(k) do { if (IN(k) && IN((k) + 1)) { XcdBarrier b_ = bar; asm volatile("" : "+s"(b_.bar)); b_.x = xb_xcc_id(); xcd_barrier(b_, MK_TID() == 0); } } while (0)

    const float* x_prompt = args.in[0]; const float* x_sample = args.in[1]; const float* state_pool = args.in[2];
    const float* norm_mix = args.in[5]; const float* norm_ffn = args.in[6];
    float* Y = args.out + O_Y;
    float* rstd0 = (float*)(ws + WS_RSTD);
    bf16_t* Xb = (bf16_t*)(ws + WS_U); bf16_t* Hb = (bf16_t*)(ws + WS_H); bf16_t* Pb = (bf16_t*)(ws + WS_H);
    u64* ss1 = (u64*)(ctl + CW_SS);
    bf16_t* Qb = (bf16_t*)(ws + WS_Q); bf16_t* Kb = (bf16_t*)(ws + WS_K); bf16_t* Vb = (bf16_t*)(ws + WS_V);
    bf16_t* CKb = (bf16_t*)(ws + WS_CK); bf16_t* CVb = (bf16_t*)(ws + WS_CV);
    bf16_t* Wpool_t = (bf16_t*)(ws + WS_WPOOL); bf16_t* Wqkv_t = (bf16_t*)(ws + WS_WQKV); bf16_t* Wo_t = (bf16_t*)(ws + WS_WO);
    bf16_t* Wgu_t = (bf16_t*)(ws + WS_WGU); bf16_t* Wd_t = (bf16_t*)(ws + WS_WD);
    const int NGW = G * 8;

    if (IN(0)) {
        PHASE_TID();
        LAS float* scr = (LAS float*)(lds + wave * 16384);
        constexpr int I_QKV = (DM / 64) * (3 * DM / 32), I_O = (DM / 64) * (DM / 32), I_G = (DM / 64) * (DFF / 32), I_D = (DFF / 64) * (DM / 32), I_P = (512 / 64) * (512 / 32);
        constexpr int NITEMS = I_QKV + I_O + 4 * I_G + 2 * I_D + 4 * I_P;
        for (int it = gw; it < NITEMS; it += NGW) {
            int r = it;
            if (r < I_QKV) { transpose_item(args.in[10], 3 * DM, Wqkv_t, DM, 0, 0, scr, r, lane, norm_mix + DM); continue; } r -= I_QKV;
            if (r < I_O) { transpose_item(args.in[18], DM, Wo_t, DM, 0, 0, scr, r, lane, nullptr); continue; } r -= I_O;
            if (r < 4 * I_G) { const int q = r / I_G, layer = q >> 1, isup = q & 1;
                transpose_item((isup ? args.in[20] : args.in[19]) + (size_t)layer * DM * DFF, DFF, Wgu_t + (size_t)layer * 2 * DFF * DM, DM, 0, 1 + isup, scr, r - q * I_G, lane, norm_ffn + layer * DM); continue; } r -= 4 * I_G;
            if (r < 2 * I_D) { const int layer = r / I_D;
                transpose_item(args.in[21] + (size_t)layer * DFF * DM, DM, Wd_t + (size_t)layer * DM * DFF, DFF, 0, 0, scr, r - layer * I_D, lane, nullptr); continue; } r -= 2 * I_D;
            { const int gidx = r / I_P; transpose_item(args.in[7] + (size_t)gidx * 512 * 512, 512, Wpool_t, 512, gidx * 512, 0, scr, r - gidx * I_P, lane, nullptr); }
        }
        for (int m = gw; m < M; m += NGW) { const float* xr = m < MP ? x_prompt + (size_t)m * DM : x_sample + (size_t)(m - MP) * DM;
            const float r = row_rstd(xr, lane); if (lane == 0) rstd0[m] = r; }
    }
    SEAM(0);
    if (IN(1)) {
        PHASE_TID();
        const int c4 = tid * 4, w = 2 << (tid >> 7);
        const f32x4 g4 = *(const f32x4*)(norm_mix + c4);
        LAS f32x4* hist = (LAS f32x4*)lds + tid;
        for (int unit = vcu; unit < 512 + 256; unit += G) {
            const bool prompt = unit < 512;
            const int b = prompt ? (unit >> 7) : ((unit - 512) >> 3), t0 = prompt ? (unit & 127) * 64 : ((unit - 512) & 7) * 8, nt = prompt ? 64 : 8, T = prompt ? SEQ : DS;
            const int mb = prompt ? b * SEQ : MP + b * DS;
            const float* xb = prompt ? x_prompt + (size_t)b * SEQ * DM : x_sample + (size_t)b * DS * DM;
            const float* stp = state_pool + (size_t)b * PST * DM;
            float* pso = args.out + (prompt ? O_PSP : O_PSS) + (size_t)b * PST * DM;
#define EXT(j) ((j) >= 0 ? (*(const f32x4*)(xb + (size_t)(j) * DM + c4) * rstd0[mb + (j)] * g4) : (prompt ? (f32x4){0.f, 0.f, 0.f, 0.f} : *(const f32x4*)(stp + (size_t)(PST + (j)) * DM + c4)))
            f32x4 S = (f32x4){0.f, 0.f, 0.f, 0.f};
            for (int j = t0 - w + 1; j < t0; ++j) { const f32x4 u = EXT(j); hist[(j & 15) * 512] = u; S += u; }
#pragma unroll 1
            for (int tb = t0; tb < t0 + nt; tb += 8) {
                f32x4 xv[8]; float rs[8];
#pragma unroll
                for (int k = 0; k < 8; ++k) { xv[k] = *(const f32x4*)(xb + (size_t)(tb + k) * DM + c4); rs[k] = rstd0[mb + tb + k]; }
#pragma unroll
                for (int k = 0; k < 8; ++k) { const int t = tb + k;
                    const f32x4 u = xv[k] * rs[k] * g4; hist[(t & 15) * 512] = u; S += u;
                    const int cnt = prompt ? ((t + 1 < w) ? t + 1 : w) : w;
                    const f32x4 p = S * (1.0f / (float)cnt) - u;
                    u32x2 o; o.x = cvt_pk_bf16(p[0], p[1]); o.y = cvt_pk_bf16(p[2], p[3]);
                    *(u32x2*)(Pb + (size_t)(mb + t) * DM + c4) = o;
                    S -= hist[((t - w + 1) & 15) * 512];
                    if (t >= T - PST) *(f32x4*)(pso + (size_t)(t - (T - PST)) * DM + c4) = u; }
            }
#undef EXT
        }
    }
    SEAM(1);
    if (IN(2)) {
        pg8::Gemm g{Pb, Wpool_t, DM, 512, 512, 2, 512}; pg8::StaticOrder S; S.init(M, DM, G, bx);
        pg8::EpiPool E{x_prompt, x_sample, Xb, ss1, args.in[8], args.in[9]};
        pg8::gemm_phase<pg8::EpiPool>(lds, g, S, E, wv);
    }
    SEAM(2);
#pragma unroll 1
    for (int layer = 0; layer < 2; ++layer) {
        if (layer == 1) {
            if (IN(6)) { PHASE_TID(); for (int m = MP + gw; m < M; m += NGW) fix_row(Xb + (size_t)m * DM, (const float*)(ws + WS_SCR) + (size_t)(m - MP) * DM, ss1 + M + m, nullptr, lane); }
            SEAM(6);
            if (IN(7)) {
                pg8::Gemm g{Xb, Wqkv_t, DM, DM, DM, 1 << 20, 0}; pg8::StaticOrder S; S.init(M, 3 * DM, G, bx);
                pg8::EpiQKV E{Qb, args.out, args.in[11], args.in[12], (LAS float*)(lds + LDSX_OFF), ss1 + M};
                pg8::gemm_phase<pg8::EpiQKV>(lds, g, S, E, wv);
            }
            SEAM(7);
            if (IN(8)) {
                PHASE_TID();
                if (wave == 0) {
                    const float* lq1 = args.in[13]; const float* lk1 = args.in[14]; const float* lq2 = args.in[15]; const float* lk2 = args.in[16];
                    float s1 = lq1[lane] * lk1[lane] + lq1[lane + 64] * lk1[lane + 64], s2 = lq2[lane] * lk2[lane] + lq2[lane + 64] * lk2[lane + 64];
                    s1 = wave_sum(s1); s2 = wave_sum(s2);
                    float gq = fmaxf(fabsf(args.in[11][lane]), fabsf(args.in[11][lane + 64])), gk = fmaxf(fabsf(args.in[12][lane]), fabsf(args.in[12][lane + 64]));
                    gq = wave_max(gq); gk = wave_max(gk);
                    if (lane == 0) { ((volatile LAS float*)MISC)[16] = expf(s1) - expf(s2) + LAM_INIT;
                                     ((volatile LAS float*)MISC)[17] = 11.313708499f * 1.4426950408889634f * 1.02f * gq * gk + 0.25f; }
                }
                __syncthreads();
                const float M2 = ((volatile LAS float*)MISC)[17];
                float* scr = (float*)(ws + WS_SCR);
                LAS unsigned char* costs = (LAS unsigned char*)(lds + LDSX_OFF + 2048); LAS unsigned short* qtab = (LAS unsigned short*)(lds + LDSX_OFF + 2048 + 256);
                const int myx = (int)(xb_xcc_id() & 7u);
#pragma unroll 1
                for (int qq = 0; qq < 8; ++qq) {
                    const int q = (myx + qq) & 7;
                    __syncthreads();
                    { int tb = MK_TID(); asm volatile("" : "+v"(tb));
                      if (tb < att::ITEMS_PER_Q) costs[tb] = (unsigned char)att::att_cost(q, tb);
                      __syncthreads();
                      if (tb < att::ITEMS_PER_Q) { const int cj = costs[tb]; int rank = 0;
                          for (int i = 0; i < att::ITEMS_PER_Q; ++i) { const int ci = costs[i]; rank += (ci > cj || (ci == cj && i < tb)) ? 1 : 0; }
                          qtab[rank] = (unsigned short)tb; } }
                    __syncthreads();
#pragma unroll 1
                    for (;;) {
                        int tq = MK_TID(); asm volatile("" : "+v"(tq));
                        const int waveq = __builtin_amdgcn_readfirstlane(tq >> 6);
                        if (tq == 0) MISC[20] = __hip_atomic_fetch_add(ctl + CW_Q + 64 * q, 1u, __ATOMIC_RELAXED, __HIP_MEMORY_SCOPE_AGENT);
                        __syncthreads();
                        const unsigned idx = MISC[20];
                        __syncthreads();
                        if (idx >= (unsigned)att::ITEMS_PER_Q) break;
                        const int j = qtab[idx];
                        bool prompt; int b, h, qb; att::att_item(q, j, prompt, b, h, qb);
                        att::UnitDesc U;
                        const size_t mrow = prompt ? (size_t)b * SEQ + (size_t)qb * 256 : (size_t)MP + (size_t)b * DS;
                        U.Q = Qb + mrow * DM + h * HD; U.O = Qb + mrow * DM + h * HD;
                        U.K1 = Kb + (prompt ? (size_t)b * SEQ : mrow) * DM + h * HD; U.V1 = Vb + (prompt ? (size_t)b * SEQ : mrow) * DM + h * HD;
                        U.K0 = prompt ? U.K1 : CKb + (size_t)b * PAST * DM + h * HD; U.V0 = prompt ? U.V1 : CVb + (size_t)b * PAST * DM + h * HD;
                        U.NT = prompt ? 4 * qb + 4 : PAST / 64 + 1; U.nt0 = prompt ? U.NT : PAST / 64;
                        U.t_lo = att::att_tlo(prompt ? qb * 256 : PAST, h);
                        U.ntw = prompt ? 4 * qb + (waveq >> 1) + 1 : (waveq < 2 ? PAST / 64 + 1 : 0);
                        U.qbase = (prompt ? qb * 256 : PAST) + waveq * 32;
                        U.slope2 = exp2f(-(float)(h + 1)) * 1.4426950408889634f;
                        U.nodma = !prompt;
                        if (!prompt && waveq >= 2) att::loader_unit(args.in[3] + (size_t)b * PAST * DM + h * HD, args.in[4] + (size_t)b * PAST * DM + h * HD, CVb + (size_t)b * PAST * DM + h * HD, U.K1, U.V1, U.t_lo, (char*)lds_raw, wv);
                        else
                        att::attn_unit(U, (const volatile LAS float*)MISC + 16, M2, args.in[17], scr, (char*)lds_raw, wv);
                    }
                }
                __syncthreads();
            }
            SEAM(8);
            if (IN(9)) {
                pg8::Gemm g{Qb, Wo_t, DM, DM, DM, 1 << 20, 0}; pg8::StaticOrder S; S.init(M, DM, G, bx, MS / 256, 4);
                pg8::EpiRes E{Xb, ss1 + 2 * M, (float*)(ws + WS_SCR), nullptr};
                pg8::gemm_phase<pg8::EpiRes>(lds, g, S, E, wv);
            }
            SEAM(9);
            if (IN(10)) { PHASE_TID(); for (int m = MP + gw; m < M; m += NGW) fix_row(Xb + (size_t)m * DM, (const float*)(ws + WS_SCR) + (size_t)(m - MP) * DM, ss1 + 2 * M + m, nullptr, lane); }
            SEAM(10);
        }
        const int p_gu = layer == 0 ? 4 : 11, p_dn = layer == 0 ? 5 : 12;
        if (IN(p_gu)) {
            pg8::Gemm g{Xb, Wgu_t + (size_t)layer * 2 * DFF * DM, DM, DM, DM, 1 << 20, 0}; pg8::StaticOrder S; S.init(M, 2 * DFF, G, bx, 0, 1, 1);
            pg8::EpiSwiglu E{Hb, ss1 + (size_t)layer * 2 * M};
            pg8::gemm_phase<pg8::EpiSwiglu>(lds, g, S, E, wv);
        }
        SEAM(p_gu);
        if (IN(p_dn)) {
            pg8::Gemm g{Hb, Wd_t + (size_t)layer * DM * DFF, DFF, DFF, DFF, 1 << 20, 0}; pg8::StaticOrder S; S.init(M, DM, G, bx, MS / 256, 4);
            pg8::EpiRes E{Xb, ss1 + M, (float*)(ws + WS_SCR), layer == 1 ? Y : nullptr};
            pg8::gemm_phase<pg8::EpiRes>(lds, g, S, E, wv);
        }
        SEAM(p_dn);
    }
    if (IN(13)) { PHASE_TID(); for (int m = MP + gw; m < M; m += NGW) fix_row(Xb + (size_t)m * DM, (const float*)(ws + WS_SCR) + (size_t)(m - MP) * DM, nullptr, Y + (size_t)m * DM, lane); }
#undef IN
#undef SEAM
}

extern "C" void kernel_launch(void* const* d_in, const int* in_sizes, int n_in, void* d_out, int out_size, void* d_ws, size_t ws_size, hipStream_t stream) {
    static int grid = 0;
    if (grid == 0) {
        if (n_in != 22 || in_sizes[0] != MP * DM || (size_t)out_size != O_END || ws_size < WS_END) {
            fprintf(stderr, "kernel_launch: shape mismatch: n_in %d in0 %d out %d ws %zu (need %zu)\n", n_in, n_in > 0 ? in_sizes[0] : -1, out_size, ws_size, (size_t)WS_END); grid = -1; return; }
        int dev = 0, cus = 0, per_cu = 0;
        if (hipGetDevice(&dev) != hipSuccess || hipDeviceGetAttribute(&cus, hipDeviceAttributeMultiprocessorCount, dev) != hipSuccess) { grid = -1; return; }
        if (hipFuncSetAttribute((const void*)mk_fwd, hipFuncAttributeMaxDynamicSharedMemorySize, LDS_BYTES) != hipSuccess) { fprintf(stderr, "kernel_launch: hipFuncSetAttribute failed\n"); grid = -1; return; }
        if (hipOccupancyMaxActiveBlocksPerMultiprocessor(&per_cu, (const void*)mk_fwd, 512, LDS_BYTES) != hipSuccess || per_cu < 1) {
            fprintf(stderr, "kernel_launch: occupancy query reports %d workgroups per CU\n", per_cu); }
        (void)hipGetLastError();
        grid = cus;
    }
    if (grid < 0) return;
    if (hipMemsetAsync((char*)d_ws + WS_CTL, 0, CTL_ZERO_BYTES, stream) != hipSuccess) { fprintf(stderr, "kernel_launch: memset failed\n"); return; }
    Args a{};
    for (int i = 0; i < 22; ++i) a.in[i] = (const float*)d_in[i];
    a.out = (float*)d_out; a.ws = (unsigned char*)d_ws;
#if MK_N_LAUNCHES == 1
    a.ph_lo = 0; a.ph_hi = N_PHASES;
    hipLaunchKernelGGL(mk_fwd, dim3(grid), dim3(512), LDS_BYTES, stream, a);
#else
    for (int p = 0; p < 14; ++p) { a.ph_lo = p; a.ph_hi = p + 1; hipLaunchKernelGGL(mk_fwd, dim3(grid), dim3(512), LDS_BYTES, stream, a); }
#endif
    const hipError_t le = hipPeekAtLastError();
    if (le != hipSuccess) fprintf(stderr, "kernel_launch: launch failed: %s\n", hipGetErrorName(le));
}
```

```cpp
#include <hip/hip_runtime.h>
#include <cstdio>
#include <cstdint>

#ifndef MK_N_LAUNCHES
#define MK_N_LAUNCHES 1
#endif

#define LAS __attribute__((address_space(3)))
typedef unsigned short bf16_t;
typedef short bf16x8 __attribute__((ext_vector_type(8)));
typedef short s16x4 __attribute__((ext_vector_type(4)));
typedef float f32x4 __attribute__((ext_vector_type(4)));
typedef float f32x2 __attribute__((ext_vector_type(2)));
typedef float f32x16 __attribute__((ext_vector_type(16)));
typedef unsigned u32x4 __attribute__((ext_vector_type(4)));
typedef unsigned u32x2 __attribute__((ext_vector_type(2)));

constexpr int DM = 2048, NB = 4, SEQ = 8192, DB = 32, DS = 64, PAST = 1024, NH = 8, HD = 256, HH = 128, DFF = 5632, PST = 15;
constexpr int MP = NB * SEQ, MS = DB * DS, M = MP + MS;
constexpr float EPS = 1e-6f;
constexpr float LAM_INIT = 0.35550907f;
constexpr float QSCALE = 0.08838834764831845f * 1.4426950408889634f;
constexpr size_t O_Y = 0, O_PSP = (size_t)M * DM, O_PSS = O_PSP + (size_t)NB * PST * DM, O_KP = O_PSS + (size_t)DB * PST * DM,
                 O_VP = O_KP + (size_t)MP * DM, O_KS = O_VP + (size_t)MP * DM, O_VS = O_KS + (size_t)MS * DM, O_END = O_VS + (size_t)MS * DM;
constexpr size_t MiB = 1u << 20;
constexpr size_t WS_CTL = 0, CTL_ZERO_BYTES = 1 * MiB, WS_RSTD = 1 * MiB, WS_WPOOL = 2 * MiB, WS_WQKV = 4 * MiB, WS_WO = 28 * MiB, WS_WGU = 36 * MiB,
                 WS_WD = 124 * MiB, WS_U = 168 * MiB, WS_H = 304 * MiB, WS_Q = 304 * MiB, WS_K = 440 * MiB, WS_V = 576 * MiB, WS_CK = 712 * MiB,
                 WS_CV = 840 * MiB, WS_SCR = 968 * MiB, WS_END = 1032 * MiB;
static_assert(WS_K - WS_Q == WS_V - WS_K && WS_H + (size_t)M * DFF * 2 <= WS_CK && WS_U + (size_t)M * DM * 2 <= WS_H && WS_WD + 2 * (size_t)DM * DFF * 2 <= WS_U, "ws map");
constexpr int CW_BAR = 4096, CW_Q = 16384, CW_SS = 32768;
constexpr int RING_BYTES = 131072, SSL_OFF = RING_BYTES  , LDSX_OFF = 147456, LDSX_BYTES = 8192, MISC_OFF = LDSX_OFF + LDSX_BYTES, LDS_BYTES = 163840;

__device__ __forceinline__ unsigned cvt_pk_bf16(float lo, float hi) { unsigned r; asm volatile("v_cvt_pk_bf16_f32 %0, %1, %2" : "=v"(r) : "v"(lo), "v"(hi)); return r; }
__device__ __forceinline__ int lane_id_v() { int x; asm volatile("v_mbcnt_lo_u32_b32 %0, -1, 0\n\tv_mbcnt_hi_u32_b32 %0, -1, %0" : "=v"(x)); return x; }
template <int K> __device__ __forceinline__ float shx(float v) { return __int_as_float(__builtin_amdgcn_ds_swizzle(__float_as_int(v), (K << 10) | 0x1F)); }
__device__ __forceinline__ float add_x32(float v) { auto rr = __builtin_amdgcn_permlane32_swap(__float_as_uint(v), __float_as_uint(v), false, false); return __uint_as_float(rr[0]) + __uint_as_float(rr[1]); }
__device__ __forceinline__ float max_x32(float v) { auto rr = __builtin_amdgcn_permlane32_swap(__float_as_uint(v), __float_as_uint(v), false, false); return fmaxf(__uint_as_float(rr[0]), __uint_as_float(rr[1])); }
__device__ __forceinline__ float wave_sum(float v) { v += shx<1>(v); v += shx<2>(v); v += shx<4>(v); v += shx<8>(v); v += shx<16>(v); return add_x32(v); }
__device__ __forceinline__ float wave_max(float v) { v = fmaxf(v, shx<1>(v)); v = fmaxf(v, shx<2>(v)); v = fmaxf(v, shx<4>(v)); v = fmaxf(v, shx<8>(v)); v = fmaxf(v, shx<16>(v)); return max_x32(v); }
#define LDS_WAIT() asm volatile("s_waitcnt lgkmcnt(0)" ::: "memory")
typedef unsigned long long u64;
constexpr float SS_SCALE = 16777216.0f, SS_INV = 1.0f / 16777216.0f;
__device__ __forceinline__ float rstd_of(u64 s) { return __builtin_amdgcn_rsqf((float)s * (SS_INV / DM) + EPS); }
__device__ __forceinline__ void ss_add(u64* p, float s) { (void)__hip_atomic_fetch_add(p, (u64)(s * SS_SCALE), __ATOMIC_RELAXED, __HIP_MEMORY_SCOPE_AGENT); }
__device__ __forceinline__ float bf_lo(unsigned w) { return __uint_as_float(w << 16); }
__device__ __forceinline__ float bf_hi(unsigned w) { return __uint_as_float(w & 0xffff0000u); }

namespace pg8 {
#define PG8_LAS __attribute__((address_space(3)))
constexpr int BM = 256, BK = 64, HALF = 128, HTB = HALF * BK * 2, STAGE_BYTES = 8 * HTB, NXCD = 8, WGM = 4;
__host__ __device__ __forceinline__ int lds_byte(int r, int c) { const int st = (r >> 4) * 2 + (c >> 5), rr = r & 15, cc = c & 31, ob = rr * 64 + cc * 2; return st * 1024 + (ob ^ (((ob >> 9) & 1) << 5)); }
__host__ __device__ __forceinline__ void stage_rc(int b, int& R, int& C) { const int st = b / 1024, sb = b % 1024, swz = sb ^ (((sb >> 9) & 1) << 5); R = (st >> 1) * 16 + swz / 64; C = (st & 1) * 32 + (swz % 64) / 2; }
__host__ __device__ __forceinline__ int perm32(int rho) { const int n = rho >> 4, i = rho & 15; return 8 * (i >> 2) + 4 * n + (i & 3); }

struct Unit { int pm, pn, kq, half; };
struct Gemm { const bf16_t* A; const bf16_t* Bt; int lda, ldb, K, a_div, a_mul; };

struct StaticOrder {
    int nM, nN, nwg, G, c, nMs, ksp, hs;
    __host__ __device__ void init(int M_, int N_, int G_, int c_, int nMs_ = 0, int ksp_ = 1, int hs_ = 0) { nMs = nMs_; ksp = ksp_; nM = M_ / BM - nMs; nN = N_ / BM; nwg = nM * nN; G = G_; c = c_; hs = hs_; }
    __host__ __device__ bool next(int i, Unit& u) const {
        long L = (long)i * G + c; u.half = -1;
        if (hs) { const int fr_ = nwg / G, rem = nwg - fr_ * G;
            if (i == fr_ && 2 * rem <= G) { if (c >= 2 * rem) return false; L = (long)fr_ * G + (c >> 1); u.half = c & 1; } }
        if (L >= nwg + (long)nMs * nN * ksp) return false;
        if (L >= nwg) { const int s_ = (int)(L - nwg), rest = s_ / ksp; u.kq = s_ - rest * ksp; u.pn = rest % nN; u.pm = nM + rest / nN; return true; }
        int wgid = (int)L; { const int q = nwg / NXCD, r = nwg % NXCD, xcd = wgid % NXCD, off = wgid / NXCD; wgid = (xcd < r ? xcd * (q + 1) : r * (q + 1) + (xcd - r) * q) + off; }
        const int nig = WGM * nN, gid = wgid / nig, fm = gid * WGM, gsz = (nM - fm) < WGM ? (nM - fm) : WGM;
        u.pm = fm + ((wgid % nig) % gsz); u.pn = (wgid % nig) / gsz; u.kq = -1; return true;
    }
};

template <class Epi>
__device__ __forceinline__ void gemm_phase(PG8_LAS unsigned char* lds, const Gemm g, const StaticOrder& S, const Epi& E, int wv) {
    int tid = (wv << 6) | lane_id_v(); asm volatile("" : "+v"(tid));
    const int wid = __builtin_amdgcn_readfirstlane(tid >> 6), lane = tid & 63, wr = wid >> 2, wc = wid & 3, fr = lane & 15, fq = lane >> 4;
    const int K = g.K;
    unsigned voffA[2], voffB[2];
#pragma unroll
    for (int i = 0; i < 2; ++i) { int R, C; stage_rc(tid * 16 + i * 8192, R, C); const int Rb = Epi::PERM ? ((R & ~31) + perm32(R & 31)) : R;
        voffA[i] = (unsigned)(R * g.lda + C) * 2u; voffB[i] = (unsigned)(Rb * g.ldb + C) * 2u; }
    const size_t kstep = (size_t)(BK * 2);
    const size_t hstepA = (size_t)HALF * g.lda * 2, hstepB = (size_t)HALF * g.ldb * 2;
    const unsigned ldsw = (unsigned)wid * 1024u;
    const int aoff = lds_byte(wr * 64 + fr, fq * 8), boff = lds_byte(wc * 32 + fr, fq * 8);
#define PG8_KOFS(u) ((u).kq < 0 ? 0 : (u).kq * (K / S.ksp))
#define PG8_NT(u) ((u).kq < 0 ? K / BK : K / S.ksp / BK)
#define PG8_APTR(u) ((const char*)g.A + ((size_t)(u).pm * BM * g.lda + (size_t)((u).pn / g.a_div) * g.a_mul + PG8_KOFS(u) + ((Epi::HALF_OK && (u).half > 0) ? (size_t)HALF * g.lda : (size_t)0)) * 2)
#define PG8_HST(u) ((Epi::HALF_OK && (u).half >= 0) ? (size_t)0 : hstepA)
#define PG8_BPTR(u) ((const char*)g.Bt + ((size_t)(u).pn * BM * g.ldb + PG8_KOFS(u)) * 2)
#define PG8_SA(b, h) (((b) * 2 + (h)) * HTB)
#define PG8_SB(b, h) ((4 + (b) * 2 + (h)) * HTB)
#define PG8_STAGE(bufoff, gbase, voff) do { _Pragma("unroll") for (int _i = 0; _i < 2; ++_i) \
        __builtin_amdgcn_global_load_lds((const unsigned*)((const char*)(gbase) + (voff)[_i]), (PG8_LAS unsigned*)(lds + (bufoff) + ldsw + _i * 8192), 16, 0, 0); } while (0)
#define PG8_LDA(dst, b, h) do { _Pragma("unroll") for (int m = 0; m < 4; ++m) _Pragma("unroll") for (int k = 0; k < 2; ++k) dst[m][k] = *(const PG8_LAS bf16x8*)(lds + PG8_SA(b, h) + aoff + m * 2048 + k * 1024); } while (0)
#define PG8_LDB(dst, b, h) do { _Pragma("unroll") for (int n = 0; n < 2; ++n) _Pragma("unroll") for (int k = 0; k < 2; ++k) dst[n][k] = *(const PG8_LAS bf16x8*)(lds + PG8_SB(b, h) + boff + n * 2048 + k * 1024); } while (0)
#define PG8_MMA(ai, bj, At, Bt) do { __builtin_amdgcn_s_setprio(1); _Pragma("unroll") for (int m = 0; m < 4; ++m) _Pragma("unroll") for (int n = 0; n < 2; ++n) _Pragma("unroll") for (int k = 0; k < 2; ++k) \
        acc[ai][bj][m][n] = __builtin_amdgcn_mfma_f32_16x16x32_bf16(Bt[n][k], At[m][k], acc[ai][bj][m][n], 0, 0, 0); __builtin_amdgcn_s_setprio(0); } while (0)
#define PG8_WAIT_V(n) asm volatile("s_waitcnt vmcnt(" #n ")" ::: "memory")
#define PG8_WAIT_L(n) asm volatile("s_waitcnt lgkmcnt(" #n ")" ::: "memory")
#define PG8_BAR __builtin_amdgcn_s_barrier()
#define PG8_SCHED __builtin_amdgcn_sched_barrier(0)
    Unit cur, nxt; int ui = 0;
    if (!S.next(0, cur)) return;
    f32x4 acc[2][2][4][2];
#pragma unroll
    for (int a = 0; a < 2; ++a)
#pragma unroll
        for (int b = 0; b < 2; ++b)
#pragma unroll
            for (int m = 0; m < 4; ++m)
#pragma unroll
                for (int n = 0; n < 2; ++n) acc[a][b][m][n] = (f32x4){0.f, 0.f, 0.f, 0.f};
    bf16x8 At[4][2], B0[2][2], B1[2][2];
    const char* cA = PG8_APTR(cur); const char* cB = PG8_BPTR(cur);
    PG8_STAGE(PG8_SB(0, 0), cB, voffB); PG8_STAGE(PG8_SB(0, 1), cB + hstepB, voffB); PG8_STAGE(PG8_SA(0, 0), cA, voffA); PG8_STAGE(PG8_SA(0, 1), cA + hstepA, voffA);
    if (wr == 1) PG8_BAR;
    PG8_WAIT_V(2); PG8_BAR;
    PG8_STAGE(PG8_SB(1, 0), cB + kstep, voffB); PG8_STAGE(PG8_SA(1, 0), cA + kstep, voffA); PG8_STAGE(PG8_SB(1, 1), cB + hstepB + kstep, voffB);
    PG8_WAIT_V(6); PG8_BAR;
    for (;;) {
        if (Epi::SS_LDS) {
            __builtin_amdgcn_global_load_lds((const unsigned*)((const char*)(E.ss + (size_t)cur.pm * BM) + wid * 256 + lane * 4), (PG8_LAS unsigned*)(lds + SSL_OFF + (ui & 1) * 2048 + wid * 256), 4, 0, 0); }
        const bool has_next = S.next(ui + 1, nxt);
        const char* nA = has_next ? PG8_APTR(nxt) : cA; const char* nB = has_next ? PG8_BPTR(nxt) : cB;
        const int nt = PG8_NT(cur);
        const bool hm = Epi::HALF_OK && cur.half >= 0;
        const size_t nhs = has_next ? PG8_HST(nxt) : PG8_HST(cur);
#define PG8_KLOOP(HM, CHS) \
        for (int t = 0; t < nt; t += 2) { \
            const bool last = (t == nt - 2); \
            const char* a1 = cA + (size_t)(t + 1) * kstep; \
            const char* a2 = last ? nA : cA + (size_t)(t + 2) * kstep; const char* b2 = last ? nB : cB + (size_t)(t + 2) * kstep; \
            const char* a3 = a2 + kstep; const char* b3 = b2 + kstep; \
              \
            PG8_LDB(B0, 0, 0); PG8_LDB(B1, 0, 1); PG8_SCHED; PG8_LDA(At, 0, 0); PG8_STAGE(PG8_SA(1, 1), a1 + (CHS), voffA); \
            PG8_WAIT_V(8); PG8_WAIT_L(0); PG8_BAR; PG8_MMA(0, 0, At, B0); PG8_MMA(0, 1, At, B1); PG8_BAR; PG8_SCHED; \
              \
            if (!(HM)) PG8_LDA(At, 0, 1); \
            PG8_STAGE(PG8_SB(0, 0), b2, voffB); PG8_STAGE(PG8_SB(0, 1), b2 + hstepB, voffB); PG8_STAGE(PG8_SA(0, 0), a2, voffA); \
            PG8_WAIT_V(8); PG8_WAIT_L(0); PG8_BAR; if (!(HM)) { PG8_MMA(1, 0, At, B0); PG8_MMA(1, 1, At, B1); } PG8_BAR; PG8_SCHED; \
              \
            PG8_LDB(B0, 1, 0); PG8_LDB(B1, 1, 1); PG8_SCHED; PG8_LDA(At, 1, 0); PG8_STAGE(PG8_SA(0, 1), a2 + (last ? nhs : (CHS)), voffA); \
            PG8_WAIT_V(8); PG8_WAIT_L(0); PG8_BAR; PG8_MMA(0, 0, At, B0); PG8_MMA(0, 1, At, B1); PG8_BAR; PG8_SCHED; \
              \
            if (!(HM)) PG8_LDA(At, 1, 1); \
            PG8_STAGE(PG8_SB(1, 0), b3, voffB); PG8_STAGE(PG8_SB(1, 1), b3 + hstepB, voffB); PG8_STAGE(PG8_SA(1, 0), a3, voffA); \
            PG8_WAIT_V(8); PG8_WAIT_L(0); PG8_BAR; if (!(HM)) { PG8_MMA(1, 0, At, B0); PG8_MMA(1, 1, At, B1); } PG8_BAR; PG8_SCHED; \
        }
        if (hm) { PG8_KLOOP(true, (size_t)0) } else { PG8_KLOOP(false, hstepA) }
#undef PG8_KLOOP
        if (wr == 0) PG8_BAR;
        E(acc, cur, wr, wc, fr, fq, (const PG8_LAS u64*)(lds + SSL_OFF + (ui & 1) * 2048));
        if (!has_next) break;
#pragma unroll
        for (int a = 0; a < 2; ++a)
#pragma unroll
            for (int b = 0; b < 2; ++b)
#pragma unroll
                for (int m = 0; m < 4; ++m)
#pragma unroll
                    for (int n = 0; n < 2; ++n) acc[a][b][m][n] = (f32x4){0.f, 0.f, 0.f, 0.f};
        cur = nxt; cA = nA; cB = nB; ++ui;
        if (wr == 1) PG8_BAR;
    }
    PG8_WAIT_V(0);
    PG8_BAR;
#undef PG8_KOFS
#undef PG8_NT
#undef PG8_APTR
#undef PG8_HST
#undef PG8_BPTR
#undef PG8_SA
#undef PG8_SB
#undef PG8_STAGE
#undef PG8_LDA
#undef PG8_LDB
#undef PG8_MMA
#undef PG8_WAIT_V
#undef PG8_WAIT_L
#undef PG8_BAR
#undef PG8_SCHED
}

struct EpiPool {
    static constexpr bool PERM = true, SS_LDS = false, HALF_OK = false;
    const float* xp; const float* xs; bf16_t* Xb; u64* ss; const float* pb; const float* ps;
    __device__ __forceinline__ void operator()(const f32x4 (&acc)[2][2][4][2], const Unit& u, int wr, int wc, int fr, int fq, const PG8_LAS u64* ssl) const {
        const int row0 = u.pm * BM + wr * 64 + fr, col0 = u.pn * BM + wc * 32 + 8 * fq;
        const float* xin = ((u.pm < MP / BM) ? xp : xs - (size_t)MP * DM) + (size_t)row0 * DM + col0;
        bf16_t* xo = Xb + (size_t)row0 * DM + col0; u64* sp = ss + row0;
        f32x4 bv[2][2], sv[2][2];
#pragma unroll
        for (int bj = 0; bj < 2; ++bj)
#pragma unroll
            for (int n = 0; n < 2; ++n) { bv[bj][n] = *(const f32x4*)(pb + col0 + bj * HALF + 4 * n); sv[bj][n] = *(const f32x4*)(ps + col0 + bj * HALF + 4 * n); }
#pragma unroll
        for (int ai = 0; ai < 2; ++ai) {
            f32x4 xv[4][2][2];
#pragma unroll
            for (int m = 0; m < 4; ++m)
#pragma unroll
                for (int bj = 0; bj < 2; ++bj)
#pragma unroll
                    for (int n = 0; n < 2; ++n) xv[m][bj][n] = *(const f32x4*)(xin + (size_t)(ai * HALF + m * 16) * DM + bj * HALF + 4 * n);
            asm volatile("" ::: "memory");
#pragma unroll
            for (int m = 0; m < 4; ++m) { float s = 0.f;
#pragma unroll
                for (int bj = 0; bj < 2; ++bj) {
                    const f32x4 y0 = xv[m][bj][0] + (acc[ai][bj][m][0] + bv[bj][0]) * sv[bj][0], y1 = xv[m][bj][1] + (acc[ai][bj][m][1] + bv[bj][1]) * sv[bj][1];
                    s += (y0[0] * y0[0] + y0[1] * y0[1]) + (y0[2] * y0[2] + y0[3] * y0[3]) + (y1[0] * y1[0] + y1[1] * y1[1]) + (y1[2] * y1[2] + y1[3] * y1[3]);
                    u32x4 w; w.x = cvt_pk_bf16(y0[0], y0[1]); w.y = cvt_pk_bf16(y0[2], y0[3]); w.z = cvt_pk_bf16(y1[0], y1[1]); w.w = cvt_pk_bf16(y1[2], y1[3]);
                    *(u32x4*)(xo + (size_t)(ai * HALF + m * 16) * DM + bj * HALF) = w; }
                s += shx<16>(s); s = add_x32(s);
                if (fq == 0) ss_add(sp + ai * HALF + m * 16, s); }
            asm volatile("" ::: "memory"); }
    }
};
struct EpiRes {
    static constexpr bool PERM = true, SS_LDS = false, HALF_OK = false;
    bf16_t* Xb; u64* ss; float* P; float* Yf;
    __device__ __forceinline__ void operator()(const f32x4 (&acc)[2][2][4][2], const Unit& u, int wr, int wc, int fr, int fq, const PG8_LAS u64* ssl) const {
        const int row0 = u.pm * BM + wr * 64 + fr, col0 = u.pn * BM + wc * 32 + 8 * fq;
        if (u.kq >= 0) {
            float* pb = P + ((size_t)u.kq * MS - MP) * DM + (size_t)row0 * DM + col0;
#pragma unroll
            for (int ai = 0; ai < 2; ++ai)
#pragma unroll
                for (int m = 0; m < 4; ++m)
#pragma unroll
                    for (int bj = 0; bj < 2; ++bj)
#pragma unroll
                        for (int n = 0; n < 2; ++n) *(f32x4*)(pb + (size_t)(ai * HALF + m * 16) * DM + bj * HALF + 4 * n) = acc[ai][bj][m][n];
            return;
        }
        bf16_t* xo = Xb + (size_t)row0 * DM + col0; u64* sp = ss + row0;
        const bool fin = Yf != nullptr;
        float* fline = Yf + (size_t)(row0 - fr + (fr & 7)) * DM + col0 + (fr >= 8 ? 4 : 0); const int dlt = 8 * DM + (fr >= 8 ? -4 : 4);
#pragma unroll
        for (int ai = 0; ai < 2; ++ai) {
            u32x4 xw[4][2];
#pragma unroll
            for (int m = 0; m < 4; ++m)
#pragma unroll
                for (int bj = 0; bj < 2; ++bj) xw[m][bj] = *(const u32x4*)(xo + (size_t)(ai * HALF + m * 16) * DM + bj * HALF);
            asm volatile("" ::: "memory");
#pragma unroll
            for (int m = 0; m < 4; ++m) { float s = 0.f; const size_t roff = (size_t)(ai * HALF + m * 16) * DM;
#pragma unroll
                for (int bj = 0; bj < 2; ++bj) { const u32x4 w_ = xw[m][bj];
                    const f32x4 y0 = (f32x4){bf_lo(w_.x), bf_hi(w_.x), bf_lo(w_.y), bf_hi(w_.y)} + acc[ai][bj][m][0], y1 = (f32x4){bf_lo(w_.z), bf_hi(w_.z), bf_lo(w_.w), bf_hi(w_.w)} + acc[ai][bj][m][1];
                    if (fin) { f32x4 da, db;
#pragma unroll
                        for (int j = 0; j < 4; ++j) { da[j] = __int_as_float(__builtin_amdgcn_update_dpp(__float_as_int(y0[j]), __float_as_int(y1[j]), 0x128, 0xf, 0xc, false));
                                                      db[j] = __int_as_float(__builtin_amdgcn_update_dpp(__float_as_int(y0[j]), __float_as_int(y1[j]), 0x128, 0xf, 0x3, false)); }
                        *(f32x4*)(fline + roff + bj * HALF) = da; *(f32x4*)(fline + dlt + roff + bj * HALF) = db;
                    } else {
                        s += (y0[0] * y0[0] + y0[1] * y0[1]) + (y0[2] * y0[2] + y0[3] * y0[3]) + (y1[0] * y1[0] + y1[1] * y1[1]) + (y1[2] * y1[2] + y1[3] * y1[3]);
                        u32x4 w; w.x = cvt_pk_bf16(y0[0], y0[1]); w.y = cvt_pk_bf16(y0[2], y0[3]); w.z = cvt_pk_bf16(y1[0], y1[1]); w.w = cvt_pk_bf16(y1[2], y1[3]);
                        *(u32x4*)(xo + roff + bj * HALF) = w; } }
                if (!fin) { s += shx<16>(s); s = add_x32(s); if (fq == 0) ss_add(sp + ai * HALF + m * 16, s); } }
            asm volatile("" ::: "memory"); }
    }
};
struct EpiSwiglu {
    static constexpr bool PERM = true, SS_LDS = true, HALF_OK = true;
    bf16_t* Hb; const u64* ss;
    __device__ __forceinline__ void operator()(const f32x4 (&acc)[2][2][4][2], const Unit& u, int wr, int wc, int fr, int fq, const PG8_LAS u64* ssl) const {
        const int hb = u.half > 0 ? HALF : 0;
        const int row0 = u.pm * BM + hb + wr * 64 + fr, col0 = u.pn * HALF + wc * 32 + 8 * fq;
        u64 sv[2][4];
#pragma unroll
        for (int ai = 0; ai < 2; ++ai)
#pragma unroll
            for (int m = 0; m < 4; ++m) sv[ai][m] = ssl[((hb + ai * HALF) & 255) + wr * 64 + fr + m * 16];
#pragma unroll
        for (int ai = 0; ai < 2; ++ai) { if (ai == 1 && u.half >= 0) break;
#pragma unroll
            for (int m = 0; m < 4; ++m) { bf16_t* rowp = Hb + (size_t)(row0 + ai * HALF + m * 16) * DFF + col0;
                const float rs = rstd_of(sv[ai][m]), nrs = -1.4426950408889634f * rs, rs2 = rs * rs;
                float hv[8], tv[8];
#pragma unroll
                for (int n = 0; n < 2; ++n)
#pragma unroll
                    for (int j = 0; j < 4; ++j) { const float ga = acc[ai][0][m][n][j], up = acc[ai][1][m][n][j]; tv[n * 4 + j] = nrs * ga; hv[n * 4 + j] = ga * up; }
#pragma unroll
                for (int k = 0; k < 8; ++k) tv[k] = __builtin_amdgcn_exp2f(tv[k]);
#pragma unroll
                for (int k = 0; k < 8; ++k) tv[k] = 1.0f + tv[k];
#pragma unroll
                for (int k = 0; k < 8; ++k) tv[k] = __builtin_amdgcn_rcpf(tv[k]);
#pragma unroll
                for (int k = 0; k < 8; ++k) hv[k] = hv[k] * (tv[k] * rs2);
                u32x4 w; w.x = cvt_pk_bf16(hv[0], hv[1]); w.y = cvt_pk_bf16(hv[2], hv[3]); w.z = cvt_pk_bf16(hv[4], hv[5]); w.w = cvt_pk_bf16(hv[6], hv[7]);
                *(u32x4*)rowp = w; } }
    }
};
struct EpiQKV {
    static constexpr bool PERM = true, SS_LDS = true, HALF_OK = false;
    bf16_t* QKVb; float* out; const float* qg; const float* kg; PG8_LAS float* tab; const u64* ss;
    __device__ __forceinline__ void operator()(const f32x4 (&acc)[2][2][4][2], const Unit& u, int wr, int wc, int fr, int fq, const PG8_LAS u64* ssl) const {
        const int sect = u.pn >> 3;
        const int row0 = u.pm * BM + wr * 64 + fr, colt = (u.pn & 7) * BM + wc * 32 + 8 * fq;
        const bool prompt = u.pm < MP / BM;
        if (sect < 2) {
#pragma unroll
            for (int ai = 0; ai < 2; ++ai)
#pragma unroll
                for (int m = 0; m < 4; ++m)
#pragma unroll
                    for (int bj = 0; bj < 2; ++bj) { const f32x4 a = acc[ai][bj][m][0], b = acc[ai][bj][m][1];
                        float s = (a[0] * a[0] + a[1] * a[1]) + (a[2] * a[2] + a[3] * a[3]) + (b[0] * b[0] + b[1] * b[1]) + (b[2] * b[2] + b[3] * b[3]);
                        s += shx<16>(s); s = add_x32(s);
                        if (fq == 0) tab[(((wr * 128 + ai * 64 + m * 16 + fr) * 2 + bj) << 2) + wc] = s; }
        }
        asm volatile("s_waitcnt lgkmcnt(0)" ::: "memory"); __builtin_amdgcn_s_barrier(); asm volatile("" ::: "memory");
        const int gcol = wc * 32 + 8 * fq;
        const float* gp = sect == 0 ? qg : kg;
        f32x4 g0 = *(const f32x4*)(gp + gcol), g1 = *(const f32x4*)(gp + gcol + 4);
        u64 sv[2][4];
#pragma unroll
        for (int ai = 0; ai < 2; ++ai)
#pragma unroll
            for (int m = 0; m < 4; ++m) sv[ai][m] = ssl[wr * 64 + fr + ai * HALF + m * 16];
        asm volatile("" : "+v"(g0), "+v"(g1));
        const float gs = sect == 0 ? QSCALE : 1.0f; g0 = g0 * gs; g1 = g1 * gs;
        bf16_t* bbase = QKVb + (size_t)sect * ((WS_K - WS_Q) / 2) + (size_t)row0 * DM + colt;
        const size_t fo = prompt ? (sect == 1 ? O_KP : O_VP) : ((sect == 1 ? O_KS : O_VS) - (size_t)MP * DM);
        float* fbase = out + fo + (size_t)row0 * DM + colt;
        const PG8_LAS float* trow = tab + ((wr * 128 + fr) << 3);
        float* fline = fbase - (size_t)fr * DM + (size_t)(fr & 7) * DM + (fr >= 8 ? 4 : 0);
        const int dlt = 8 * DM + (fr >= 8 ? -4 : 4);
#pragma unroll
        for (int ai = 0; ai < 2; ++ai)
#pragma unroll
            for (int m = 0; m < 4; ++m) { const size_t roff = (size_t)(ai * HALF + m * 16) * DM; const float rin = rstd_of(sv[ai][m]);
#pragma unroll
                for (int bj = 0; bj < 2; ++bj) { f32x4 v0 = acc[ai][bj][m][0], v1 = acc[ai][bj][m][1];
                    if (sect < 2) { const f32x4 t = *(const PG8_LAS f32x4*)(trow + (((ai * 64 + m * 16) * 2 + bj) << 2));
                        const float r = rin * __builtin_amdgcn_rsqf(rin * rin * ((t[0] + t[1]) + (t[2] + t[3])) * (1.0f / 128.0f) + EPS); v0 = v0 * r * g0; v1 = v1 * r * g1; }
                    else { v0 = v0 * rin; v1 = v1 * rin; }
                    if (sect > 0) {
                        f32x4 da, db;
#pragma unroll
                        for (int j = 0; j < 4; ++j) { da[j] = __int_as_float(__builtin_amdgcn_update_dpp(__float_as_int(v0[j]), __float_as_int(v1[j]), 0x128, 0xf, 0xc, false));
                                                      db[j] = __int_as_float(__builtin_amdgcn_update_dpp(__float_as_int(v0[j]), __float_as_int(v1[j]), 0x128, 0xf, 0x3, false)); }
                        *(f32x4*)(fline + roff + bj * HALF) = da; *(f32x4*)(fline + dlt + roff + bj * HALF) = db; }
                    u32x4 w; w.x = cvt_pk_bf16(v0[0], v0[1]); w.y = cvt_pk_bf16(v0[2], v0[3]); w.z = cvt_pk_bf16(v1[0], v1[1]); w.w = cvt_pk_bf16(v1[2], v1[3]);
                    *(u32x4*)(bbase + roff + bj * HALF) = w; }
                asm volatile("" ::: "memory"); }
    }
};
}

namespace att {
constexpr int SHM_V = 64 * 128 * 2, SHM_K = 64 * 128 * 2, TILE_B = SHM_K + 2 * SHM_V;
constexpr int LDK = DM;
#define KSWZ(row, colB) ((row) * 256 + ((colB) ^ (((row) & 7) << 4)))
#define SBAR() __builtin_amdgcn_sched_barrier(0)
__device__ __forceinline__ int crow(int r, int hi) { return (r & 3) + 8 * (r >> 2) + 4 * hi; }
__device__ __forceinline__ int v_rd_base(int lane) { return ((lane & 3) << 3) | (((lane >> 2) & 3) << 6) | (((lane >> 4) & 1) << 5) | (((lane >> 5) & 1) << 8); }
constexpr int v_rd_off(int d0, int ks, int half) { return d0 * 512 + ks * 4096 + half * 2048; }
template <int OFF> __device__ __forceinline__ s16x4 tr_read(int vb) {
    s16x4 r; asm volatile("ds_read_b64_tr_b16 %0, %1 offset:%2" : "=&v"(r) : "v"(vb), "i"(OFF) : "memory"); return r;
}
__device__ __forceinline__ float vadd_s(float s, float v) { float d; asm("v_add_f32 %0, %1, %2" : "=v"(d) : "s"(s), "v"(v)); return d; }
__device__ __forceinline__ float vfma_abs(float x, float a, float c) { float d; asm("v_fma_f32 %0, |%1|, %2, %3" : "=v"(d) : "v"(x), "v"(a), "s"(c)); return d; }
__device__ __forceinline__ void bias_linear16(f32x16& p, float base, float s1, float s2, float s3, float s8) {
    float b = base;
#pragma unroll
    for (int k = 0; k < 4; ++k) { p[4 * k] = b; p[4 * k + 1] = vadd_s(s1, b); p[4 * k + 2] = vadd_s(s2, b); p[4 * k + 3] = vadd_s(s3, b); b = vadd_s(s8, b); }
}
__device__ __forceinline__ void bias_diag16(f32x16& p, float dq, float nslope, float nM2, float m8) {
    float t = dq;
#pragma unroll
    for (int k = 0; k < 4; ++k) { const float t1 = t - 1.0f, t2 = t - 2.0f, t3 = t1 - 2.0f;
        p[4 * k] = vfma_abs(t, nslope, nM2); p[4 * k + 1] = vfma_abs(t1, nslope, nM2); p[4 * k + 2] = vfma_abs(t2, nslope, nM2); p[4 * k + 3] = vfma_abs(t3, nslope, nM2); t = vadd_s(m8, t); }
}
template <int OFF> __device__ __forceinline__ bf16x8 lds_rd128(int addr) { bf16x8 r; asm volatile("ds_read_b128 %0, %1 offset:%2" : "=&v"(r) : "v"(addr), "i"(OFF) : "memory"); return r; }
#define LGKM(n) asm volatile("s_waitcnt lgkmcnt(" #n ")" ::: "memory")
__device__ __forceinline__ bf16x8 vfrag(s16x4 l, s16x4 h) { return (bf16x8){l[0], l[1], l[2], l[3], h[0], h[1], h[2], h[3]}; }
__device__ __forceinline__ void tile_body3(f32x16& p, f32x16* o, float& l_acc, const bf16x8* qr, int ka0, int ka1, int ka2, int ka3, int vb, float bias1  ,
                                           bool diag, float dq, float nslope, float nM2, float m8, float s1, float s2, float s3, float s8) {
#define KRD(half, d0) (((d0) & 3) == 0 ? lds_rd128<((d0) >> 2) * 128 + (half) * 8192>(ka0) : ((d0) & 3) == 1 ? lds_rd128<((d0) >> 2) * 128 + (half) * 8192>(ka1) : ((d0) & 3) == 2 ? lds_rd128<((d0) >> 2) * 128 + (half) * 8192>(ka2) : lds_rd128<((d0) >> 2) * 128 + (half) * 8192>(ka3))
#define VOFF(ks, d0, hl) (((d0) >> 2) * 16384 + v_rd_off((d0) & 3, ks, hl))
#define VRD(L_, H_, ks, d0) do { L_ = tr_read<VOFF(ks, d0, 0)>(vb); H_ = tr_read<VOFF(ks, d0, 1)>(vb); } while (0)
#define EXP1(P, S, i) do { P[i] = __builtin_amdgcn_exp2f(P[i]); S += P[i]; } while (0)
#define PK4(P, BASE, OUT) do { unsigned a0_ = cvt_pk_bf16(P[BASE + 0], P[BASE + 1]), a1_ = cvt_pk_bf16(P[BASE + 2], P[BASE + 3]);   \
    unsigned b0_ = cvt_pk_bf16(P[BASE + 4], P[BASE + 5]), b1_ = cvt_pk_bf16(P[BASE + 6], P[BASE + 7]);                              \
    auto r0_ = __builtin_amdgcn_permlane32_swap(a0_, b0_, false, false); auto r1_ = __builtin_amdgcn_permlane32_swap(a1_, b1_, false, false); \
    u32x4 w_ = {r0_[0], r1_[0], r0_[1], r1_[1]}; OUT = *reinterpret_cast<bf16x8*>(&w_); } while (0)
    bf16x8 k0, k1; s16x4 vl0, vh0, vl1, vh1; bf16x8 paX, paY; float ps = 0.f;
    k0 = KRD(0, 0);
    k1 = KRD(0, 1); LGKM(1); SBAR(); p = __builtin_amdgcn_mfma_f32_32x32x16_bf16(k0, qr[0], p, 0, 0, 0); SBAR();
    k0 = KRD(0, 2); LGKM(1); SBAR(); p = __builtin_amdgcn_mfma_f32_32x32x16_bf16(k1, qr[1], p, 0, 0, 0); SBAR();
    k1 = KRD(0, 3); LGKM(1); SBAR(); p = __builtin_amdgcn_mfma_f32_32x32x16_bf16(k0, qr[2], p, 0, 0, 0); SBAR();
    k0 = KRD(0, 4); LGKM(1); SBAR(); p = __builtin_amdgcn_mfma_f32_32x32x16_bf16(k1, qr[3], p, 0, 0, 0); SBAR();
    k1 = KRD(0, 5); LGKM(1); SBAR(); p = __builtin_amdgcn_mfma_f32_32x32x16_bf16(k0, qr[4], p, 0, 0, 0); SBAR();
    k0 = KRD(0, 6); LGKM(1); SBAR(); p = __builtin_amdgcn_mfma_f32_32x32x16_bf16(k1, qr[5], p, 0, 0, 0); SBAR();
    k1 = KRD(0, 7); LGKM(1); SBAR(); p = __builtin_amdgcn_mfma_f32_32x32x16_bf16(k0, qr[6], p, 0, 0, 0); SBAR();
    VRD(vl0, vh0, 0, 0); LGKM(2); SBAR(); p = __builtin_amdgcn_mfma_f32_32x32x16_bf16(k1, qr[7], p, 0, 0, 0); SBAR();
    EXP1(p, ps, 0); EXP1(p, ps, 1); EXP1(p, ps, 2); EXP1(p, ps, 3); EXP1(p, ps, 4); EXP1(p, ps, 5); EXP1(p, ps, 6); EXP1(p, ps, 7); PK4(p, 0, paX); SBAR();
    VRD(vl1, vh1, 0, 1); LGKM(2); SBAR(); o[0] = __builtin_amdgcn_mfma_f32_32x32x16_bf16(paX, vfrag(vl0, vh0), o[0], 0, 0, 0); EXP1(p, ps, 8); SBAR();
    VRD(vl0, vh0, 0, 2); LGKM(2); SBAR(); o[1] = __builtin_amdgcn_mfma_f32_32x32x16_bf16(paX, vfrag(vl1, vh1), o[1], 0, 0, 0); EXP1(p, ps, 9); SBAR();
    VRD(vl1, vh1, 0, 3); LGKM(2); SBAR(); o[2] = __builtin_amdgcn_mfma_f32_32x32x16_bf16(paX, vfrag(vl0, vh0), o[2], 0, 0, 0); EXP1(p, ps, 10); SBAR();
    VRD(vl0, vh0, 0, 4); LGKM(2); SBAR(); o[3] = __builtin_amdgcn_mfma_f32_32x32x16_bf16(paX, vfrag(vl1, vh1), o[3], 0, 0, 0); EXP1(p, ps, 11); SBAR();
    VRD(vl1, vh1, 0, 5); LGKM(2); SBAR(); o[4] = __builtin_amdgcn_mfma_f32_32x32x16_bf16(paX, vfrag(vl0, vh0), o[4], 0, 0, 0); EXP1(p, ps, 12); SBAR();
    VRD(vl0, vh0, 0, 6); LGKM(2); SBAR(); o[5] = __builtin_amdgcn_mfma_f32_32x32x16_bf16(paX, vfrag(vl1, vh1), o[5], 0, 0, 0); EXP1(p, ps, 13); SBAR();
    VRD(vl1, vh1, 0, 7); LGKM(2); SBAR(); o[6] = __builtin_amdgcn_mfma_f32_32x32x16_bf16(paX, vfrag(vl0, vh0), o[6], 0, 0, 0); EXP1(p, ps, 14); SBAR();
    VRD(vl0, vh0, 1, 0); LGKM(2); SBAR(); o[7] = __builtin_amdgcn_mfma_f32_32x32x16_bf16(paX, vfrag(vl1, vh1), o[7], 0, 0, 0); EXP1(p, ps, 15); SBAR();
    PK4(p, 8, paY); SBAR();
    VRD(vl1, vh1, 1, 1); LGKM(2); SBAR(); o[0] = __builtin_amdgcn_mfma_f32_32x32x16_bf16(paY, vfrag(vl0, vh0), o[0], 0, 0, 0); SBAR();
    VRD(vl0, vh0, 1, 2); LGKM(2); SBAR(); o[1] = __builtin_amdgcn_mfma_f32_32x32x16_bf16(paY, vfrag(vl1, vh1), o[1], 0, 0, 0); SBAR();
    VRD(vl1, vh1, 1, 3); LGKM(2); SBAR(); o[2] = __builtin_amdgcn_mfma_f32_32x32x16_bf16(paY, vfrag(vl0, vh0), o[2], 0, 0, 0); SBAR();
    VRD(vl0, vh0, 1, 4); LGKM(2); SBAR(); o[3] = __builtin_amdgcn_mfma_f32_32x32x16_bf16(paY, vfrag(vl1, vh1), o[3], 0, 0, 0); SBAR();
    VRD(vl1, vh1, 1, 5); LGKM(2); SBAR(); o[4] = __builtin_amdgcn_mfma_f32_32x32x16_bf16(paY, vfrag(vl0, vh0), o[4], 0, 0, 0); SBAR();
    VRD(vl0, vh0, 1, 6); LGKM(2); SBAR(); o[5] = __builtin_amdgcn_mfma_f32_32x32x16_bf16(paY, vfrag(vl1, vh1), o[5], 0, 0, 0); SBAR();
    VRD(vl1, vh1, 1, 7); LGKM(2); SBAR(); o[6] = __builtin_amdgcn_mfma_f32_32x32x16_bf16(paY, vfrag(vl0, vh0), o[6], 0, 0, 0); SBAR();
    k0 = KRD(1, 0); LGKM(1); SBAR(); o[7] = __builtin_amdgcn_mfma_f32_32x32x16_bf16(paY, vfrag(vl1, vh1), o[7], 0, 0, 0); SBAR();
    if (diag) bias_diag16(p, dq - 32.0f, nslope, nM2, m8); else bias_linear16(p, bias1, s1, s2, s3, s8);
    SBAR();
    k1 = KRD(1, 1); LGKM(1); SBAR(); p = __builtin_amdgcn_mfma_f32_32x32x16_bf16(k0, qr[0], p, 0, 0, 0); SBAR();
    k0 = KRD(1, 2); LGKM(1); SBAR(); p = __builtin_amdgcn_mfma_f32_32x32x16_bf16(k1, qr[1], p, 0, 0, 0); SBAR();
    k1 = KRD(1, 3); LGKM(1); SBAR(); p = __builtin_amdgcn_mfma_f32_32x32x16_bf16(k0, qr[2], p, 0, 0, 0); SBAR();
    k0 = KRD(1, 4); LGKM(1); SBAR(); p = __builtin_amdgcn_mfma_f32_32x32x16_bf16(k1, qr[3], p, 0, 0, 0); SBAR();
    k1 = KRD(1, 5); LGKM(1); SBAR(); p = __builtin_amdgcn_mfma_f32_32x32x16_bf16(k0, qr[4], p, 0, 0, 0); SBAR();
    k0 = KRD(1, 6); LGKM(1); SBAR(); p = __builtin_amdgcn_mfma_f32_32x32x16_bf16(k1, qr[5], p, 0, 0, 0); SBAR();
    k1 = KRD(1, 7); LGKM(1); SBAR(); p = __builtin_amdgcn_mfma_f32_32x32x16_bf16(k0, qr[6], p, 0, 0, 0); SBAR();
    VRD(vl0, vh0, 2, 0); LGKM(2); SBAR(); p = __builtin_amdgcn_mfma_f32_32x32x16_bf16(k1, qr[7], p, 0, 0, 0); SBAR();
    EXP1(p, ps, 0); EXP1(p, ps, 1); EXP1(p, ps, 2); EXP1(p, ps, 3); EXP1(p, ps, 4); EXP1(p, ps, 5); EXP1(p, ps, 6); EXP1(p, ps, 7); PK4(p, 0, paX); SBAR();
    VRD(vl1, vh1, 2, 1); LGKM(2); SBAR(); o[0] = __builtin_amdgcn_mfma_f32_32x32x16_bf16(paX, vfrag(vl0, vh0), o[0], 0, 0, 0); EXP1(p, ps, 8); SBAR();
    VRD(vl0, vh0, 2, 2); LGKM(2); SBAR(); o[1] = __builtin_amdgcn_mfma_f32_32x32x16_bf16(paX, vfrag(vl1, vh1), o[1], 0, 0, 0); EXP1(p, ps, 9); SBAR();
    VRD(vl1, vh1, 2, 3); LGKM(2); SBAR(); o[2] = __builtin_amdgcn_mfma_f32_32x32x16_bf16(paX, vfrag(vl0, vh0), o[2], 0, 0, 0); EXP1(p, ps, 10); SBAR();
    VRD(vl0, vh0, 2, 4); LGKM(2); SBAR(); o[3] = __builtin_amdgcn_mfma_f32_32x32x16_bf16(paX, vfrag(vl1, vh1), o[3], 0, 0, 0); EXP1(p, ps, 11); SBAR();
    VRD(vl1, vh1, 2, 5); LGKM(2); SBAR(); o[4] = __builtin_amdgcn_mfma_f32_32x32x16_bf16(paX, vfrag(vl0, vh0), o[4], 0, 0, 0); EXP1(p, ps, 12); SBAR();
    VRD(vl0, vh0, 2, 6); LGKM(2); SBAR(); o[5] = __builtin_amdgcn_mfma_f32_32x32x16_bf16(paX, vfrag(vl1, vh1), o[5], 0, 0, 0); EXP1(p, ps, 13); SBAR();
    VRD(vl1, vh1, 2, 7); LGKM(2); SBAR(); o[6] = __builtin_amdgcn_mfma_f32_32x32x16_bf16(paX, vfrag(vl0, vh0), o[6], 0, 0, 0); EXP1(p, ps, 14); SBAR();
    VRD(vl0, vh0, 3, 0); LGKM(2); SBAR(); o[7] = __builtin_amdgcn_mfma_f32_32x32x16_bf16(paX, vfrag(vl1, vh1), o[7], 0, 0, 0); EXP1(p, ps, 15); SBAR();
    PK4(p, 8, paY); SBAR();
    VRD(vl1, vh1, 3, 1); LGKM(2); SBAR(); o[0] = __builtin_amdgcn_mfma_f32_32x32x16_bf16(paY, vfrag(vl0, vh0), o[0], 0, 0, 0); SBAR();
    VRD(vl0, vh0, 3, 2); LGKM(2); SBAR(); o[1] = __builtin_amdgcn_mfma_f32_32x32x16_bf16(paY, vfrag(vl1, vh1), o[1], 0, 0, 0); SBAR();
    VRD(vl1, vh1, 3, 3); LGKM(2); SBAR(); o[2] = __builtin_amdgcn_mfma_f32_32x32x16_bf16(paY, vfrag(vl0, vh0), o[2], 0, 0, 0); SBAR();
    VRD(vl0, vh0, 3, 4); LGKM(2); SBAR(); o[3] = __builtin_amdgcn_mfma_f32_32x32x16_bf16(paY, vfrag(vl1, vh1), o[3], 0, 0, 0); SBAR();
    VRD(vl1, vh1, 3, 5); LGKM(2); SBAR(); o[4] = __builtin_amdgcn_mfma_f32_32x32x16_bf16(paY, vfrag(vl0, vh0), o[4], 0, 0, 0); SBAR();
    VRD(vl0, vh0, 3, 6); LGKM(2); SBAR(); o[5] = __builtin_amdgcn_mfma_f32_32x32x16_bf16(paY, vfrag(vl1, vh1), o[5], 0, 0, 0); SBAR();
    VRD(vl1, vh1, 3, 7); LGKM(2); SBAR(); o[6] = __builtin_amdgcn_mfma_f32_32x32x16_bf16(paY, vfrag(vl0, vh0), o[6], 0, 0, 0); SBAR();
    LGKM(0); SBAR(); o[7] = __builtin_amdgcn_mfma_f32_32x32x16_bf16(paY, vfrag(vl1, vh1), o[7], 0, 0, 0); SBAR();
    l_acc += ps;
#undef KRD
#undef VOFF
#undef VRD
#undef EXP1
#undef PK4
}
#undef LGKM
__device__ __forceinline__ int att_tlo(int P0, int h) {
    const float wd = 150.0f / (exp2f(-(float)(h + 1)) * 1.4426950408889634f);
    const float x = ((float)P0 - 63.0f - wd) * (1.0f / 64.0f);
    return x > 0.f ? (int)x : 0;
}
constexpr int ITEMS_PER_Q = 160;
__device__ __forceinline__ void att_item(int q, int j, bool& prompt, int& b, int& h, int& qb) {
    prompt = j < 128;
    if (prompt) { const int hs = j >> 5; b = q >> 1; h = (((q & 1) ? 0x3416 : 0x2507) >> (4 * hs)) & 15; qb = j & 31; }
    else { const int s_ = j - 128; b = 4 * q + (s_ >> 3); h = s_ & 7; qb = 0; }
}
__device__ __forceinline__ int att_cost(int q, int j) {
    bool prompt; int b, h, qb; att_item(q, j, prompt, b, h, qb);
    return prompt ? (4 * qb + 4 - att_tlo(qb * 256, h)) : 22 + ((j - 128) * 106) / 31;
}
struct UnitDesc {
    const bf16_t* Q;
    const bf16_t* K0; const bf16_t* V0; int nt0;
    const bf16_t* K1; const bf16_t* V1;
    bf16_t* O;
    int NT;
    int t_lo;
    int ntw;
    int qbase;
    float slope2;
    bool nodma;
};
__device__ __forceinline__ void attn_unit(const UnitDesc& U, const volatile LAS float* lamp, float M2, const float* subln, float* scr, char* lds, int wv) {
    int tid = (wv << 6) | lane_id_v(); asm volatile("" : "+v"(tid));
    const int wid = __builtin_amdgcn_readfirstlane(tid >> 6), lane = tid & 63, r32 = lane & 31, hi = lane >> 5;
    LAS unsigned char* ldsl = (LAS unsigned char*)lds;
    const int kl0 = (int)(uintptr_t)lds, vb0 = (int)(uintptr_t)lds + SHM_K + v_rd_base(lane);
    unsigned kof0, kof1, vof0, vof1;
    { const int p0_ = wid * 1024 + lane * 16, p1_ = p0_ + 8192;
      { const int row = p0_ >> 8, x = p0_ & 255; kof0 = (unsigned)(row * LDK * 2 + (x ^ ((row & 7) << 4))); }
      { const int row = p1_ >> 8, x = p1_ & 255; kof1 = (unsigned)(row * LDK * 2 + (x ^ ((row & 7) << 4))); }
      { const int st = p0_ >> 9, y = p0_ & 511, kk = (st >> 2) * 8 + (y >> 6), k = (kk & ~0xC) | ((kk & 4) << 1) | ((kk & 8) >> 1), c = (st & 3) * 32 + ((y & 63) >> 1); vof0 = (unsigned)(k * LDK * 2 + c * 2); }
      { const int st = p1_ >> 9, y = p1_ & 511, kk = (st >> 2) * 8 + (y >> 6), k = (kk & ~0xC) | ((kk & 4) << 1) | ((kk & 8) >> 1), c = (st & 3) * 32 + ((y & 63) >> 1); vof1 = (unsigned)(k * LDK * 2 + c * 2); } }
    const int NT = U.NT, ntw = U.ntw, nt0 = U.nt0, t_lo = U.t_lo;
    int tlo_w;
    { const float x_ = ((float)U.qbase - 63.0f - 150.0f / U.slope2) * (1.0f / 64.0f); tlo_w = __builtin_amdgcn_readfirstlane(x_ > 0.f ? (int)x_ : 0); }
    const float slope2 = U.slope2, s2x = 2.f * slope2, s3x = 3.f * slope2, s8x = 8.f * slope2, nM2 = -M2;
    float nslope = -slope2; asm volatile("" : "+v"(nslope));
    float m8 = -8.0f; asm volatile("" : "+s"(m8));
    float l_reg = 0.f; f32x16 o[8];
#pragma unroll 1
    for (int pass = 0; pass < 2; ++pass) {
        const int c = pass;
        float qp4; { int lp_ = lane_id_v(); qp4 = (float)(U.qbase + (lp_ & 31) - 4 * (lp_ >> 5)); }
        const bf16_t* Kh0 = U.K0 + c * HH; const bf16_t* Kh1 = U.K1 + c * HH; const bf16_t* Vh0 = U.V0; const bf16_t* Vh1 = U.V1;
        bf16x8 qr[8];
        if (ntw > 0) {
            const bf16_t* Qw = U.Q + (size_t)(wid * 32 + r32) * LDK + c * HH + hi * 8;
#pragma unroll
            for (int d0 = 0; d0 < 8; ++d0) qr[d0] = *reinterpret_cast<const bf16x8*>(Qw + d0 * 16);
#pragma unroll
            for (int d0 = 0; d0 < 8; ++d0) asm volatile("" : "+v"(qr[d0]));
        } else {
#pragma unroll
            for (int d0 = 0; d0 < 8; ++d0) qr[d0] = (bf16x8){0, 0, 0, 0, 0, 0, 0, 0};
        }
        l_reg = 0.f;
#pragma unroll
        for (int d0 = 0; d0 < 8; ++d0) o[d0] = f32x16{};
#define TKP(t) (((t) < nt0) ? (Kh0 + (size_t)(t) * 64 * LDK) : (Kh1 + (size_t)((t) - nt0) * 64 * LDK))
#define TVP(t) (((t) < nt0) ? (Vh0 + (size_t)(t) * 64 * LDK) : (Vh1 + (size_t)((t) - nt0) * 64 * LDK))
#define DMA_TILE(t_, bsel_) do { const int tt_ = (t_) < NT ? (t_) : NT - 1; const char* kp_ = (const char*)TKP(tt_); const char* vp_ = (const char*)TVP(tt_); \
    LAS unsigned char* bb_ = ldsl + (bsel_) * TILE_B + wid * 1024; \
    __builtin_amdgcn_global_load_lds((const unsigned*)(kp_ + kof0), (LAS unsigned*)(bb_), 16, 0, 0); \
    __builtin_amdgcn_global_load_lds((const unsigned*)(kp_ + kof1), (LAS unsigned*)(bb_ + 8192), 16, 0, 0); \
    __builtin_amdgcn_global_load_lds((const unsigned*)(vp_ + vof0), (LAS unsigned*)(bb_ + SHM_K), 16, 0, 0); \
    __builtin_amdgcn_global_load_lds((const unsigned*)(vp_ + vof1), (LAS unsigned*)(bb_ + SHM_K + 8192), 16, 0, 0); \
    __builtin_amdgcn_global_load_lds((const unsigned*)(vp_ + vof0 + 256), (LAS unsigned*)(bb_ + SHM_K + SHM_V), 16, 0, 0); \
    __builtin_amdgcn_global_load_lds((const unsigned*)(vp_ + vof1 + 256), (LAS unsigned*)(bb_ + SHM_K + SHM_V + 8192), 16, 0, 0); } while (0)
#define BARX() do { asm volatile("" ::: "memory"); __builtin_amdgcn_s_barrier(); asm volatile("" ::: "memory"); } while (0)
        f32x16 pA0;
        asm volatile("s_waitcnt vmcnt(0) lgkmcnt(0)" ::: "memory"); BARX();
        if (!U.nodma) { DMA_TILE(t_lo, 0); DMA_TILE(t_lo + 1, 1); }
        asm volatile("s_waitcnt vmcnt(6)" ::: "memory"); BARX();
        int bsel = 0;
#pragma unroll 1
        for (int t = t_lo; t < NT; ++t) {
            const int bn = bsel == 0 ? 2 : bsel - 1;
            if (!U.nodma && wid >= 4) DMA_TILE(t + 2, bn);
            SBAR();
            if (t >= tlo_w && t < ntw) {
                const float dq_ = qp4 - (float)(64 * t); const bool diag_ = (t == ntw - 1); const float base0_ = fmaf(nslope, dq_, nM2);
                if (diag_) bias_diag16(pA0, dq_, nslope, nM2, m8); else bias_linear16(pA0, base0_, slope2, s2x, s3x, s8x);
                { const int kb_ = kl0 + bsel * TILE_B;
                  tile_body3(pA0, o, l_reg, qr, kb_ + KSWZ(r32, (0 * 16 + hi * 8) * 2), kb_ + KSWZ(r32, (1 * 16 + hi * 8) * 2), kb_ + KSWZ(r32, (2 * 16 + hi * 8) * 2), kb_ + KSWZ(r32, (3 * 16 + hi * 8) * 2), vb0 + bsel * TILE_B,
                             fmaf(32.0f, slope2, base0_), diag_, dq_, nslope, nM2, m8, slope2, s2x, s3x, s8x); }
            }
            SBAR();
            if (!U.nodma && wid < 4) DMA_TILE(t + 2, bn);
            asm volatile("s_waitcnt vmcnt(6) lgkmcnt(0)" ::: "memory"); BARX();
            bsel = bsel == 2 ? 0 : bsel + 1;
        }
        asm volatile("s_waitcnt vmcnt(0)" ::: "memory");
#undef TKP
#undef TVP
#undef DMA_TILE
#undef BARX
        { auto rr = __builtin_amdgcn_permlane32_swap(__float_as_uint(l_reg), __float_as_uint(l_reg), false, false); l_reg = __uint_as_float(rr[0]) + __uint_as_float(rr[1]); }
        if (ntw > 0 && pass == 0) {
            int le_ = lane_id_v(); const int r32 = le_ & 31, hi = le_ >> 5;
            float* li_l = (float*)(lds + LDSX_OFF) + wid * 64;
            float* myscr = scr + ((size_t)(blockIdx.x * 8 + wid) * 64 + le_) * 128;
            if (hi == 0) li_l[r32] = l_reg;
            asm volatile("s_waitcnt lgkmcnt(0)" ::: "memory");
#pragma unroll
            for (int d0 = 0; d0 < 8; ++d0)
#pragma unroll
                for (int k = 0; k < 4; ++k) { f32x4 t;
#pragma unroll
                    for (int j = 0; j < 4; ++j) t[j] = o[d0][4 * k + j] * __builtin_amdgcn_rcpf(li_l[crow(4 * k + j, hi)]);
                    *(f32x4*)(myscr + d0 * 16 + 4 * k) = t; }
            asm volatile("s_waitcnt lgkmcnt(0)" ::: "memory");
        }
    }
    asm volatile("" ::: "memory"); __builtin_amdgcn_s_barrier(); asm volatile("" ::: "memory");
    if (ntw > 0) {
        int le_ = lane_id_v(); const int r32 = le_ & 31, hi = le_ >> 5;
        const float lam = *lamp;
        float* li_l = (float*)(lds + LDSX_OFF) + wid * 64;
        float* myscr = scr + ((size_t)(blockIdx.x * 8 + wid) * 64 + le_) * 128;
        if (hi == 0) li_l[r32] = l_reg;
        asm volatile("s_waitcnt lgkmcnt(0)" ::: "memory");
        float ss[16];
#pragma unroll
        for (int r = 0; r < 16; ++r) { ss[r] = 0.f; const float rl = lam * __builtin_amdgcn_rcpf(li_l[crow(r, hi)]);
#pragma unroll
            for (int d0 = 0; d0 < 8; ++d0) o[d0][r] *= rl; }
#pragma unroll
        for (int d0 = 0; d0 < 8; ++d0)
#pragma unroll
            for (int k = 0; k < 4; ++k) { const f32x4 t1 = *(const f32x4*)(myscr + d0 * 16 + 4 * k);
#pragma unroll
                for (int j = 0; j < 4; ++j) { const float t = t1[j] - o[d0][4 * k + j]; o[d0][4 * k + j] = t; ss[4 * k + j] += t * t; } }
#pragma unroll
        for (int r = 0; r < 16; ++r) {
            ss[r] += shx<1>(ss[r]); ss[r] += shx<2>(ss[r]); ss[r] += shx<4>(ss[r]); ss[r] += shx<8>(ss[r]); ss[r] += shx<16>(ss[r]);
            ss[r] = (1.0f - LAM_INIT) * __builtin_amdgcn_rsqf(ss[r] * (1.0f / 256.0f) + EPS); }
        LAS unsigned char* ob = (LAS unsigned char*)lds + wid * 16896;
        const int wofs = (4 * hi) * 528 + r32 * 2;
#pragma unroll
        for (int d0 = 0; d0 < 8; ++d0) { const float g = subln[d0 * 32 + r32];
#pragma unroll
            for (int r = 0; r < 16; ++r) {
                const float v = o[d0][r] * ss[r] * g; const float vn = shx<1>(v);
                if ((r32 & 1) == 0) *(LAS unsigned*)(ob + wofs + ((r & 3) + 8 * (r >> 2)) * 528 + d0 * 64) = cvt_pk_bf16(v, vn); }
            asm volatile("" ::: "memory"); }
        asm volatile("s_waitcnt lgkmcnt(0)" ::: "memory");
        bf16_t* Ow = U.O + (size_t)(wid * 32 + hi) * LDK + r32 * 8;
#pragma unroll
        for (int i = 0; i < 16; ++i) { const u32x4 w_ = *(const LAS u32x4*)(ob + (2 * i + hi) * 528 + r32 * 16); *(u32x4*)(Ow + (size_t)(2 * i) * LDK) = w_; }
    }
}

__device__ __forceinline__ void loader_unit(const float* ckf, const float* cvf  , bf16_t* cvb  , const bf16_t* K1, const bf16_t* V1  , int t_lo, char* lds, int wv) {
    int tid = (wv << 6) | lane_id_v(); asm volatile("" : "+v"(tid));
    const int wid = __builtin_amdgcn_readfirstlane(tid >> 6), lane = tid & 63, lw = wid - 2;
    constexpr int NT = PAST / 64 + 1, NC = PAST / 64;
    LAS unsigned char* ldsl = (LAS unsigned char*)lds;
    unsigned soff[8];
#pragma unroll
    for (int i = 0; i < 8; ++i) { const int g = lw + 6 * i;
        if (g < 16) { const int p_ = g * 1024 + lane * 16, row = p_ >> 8, x = p_ & 255; soff[i] = (unsigned)(row * LDK * 2 + (x ^ ((row & 7) << 4))); }
        else { const int gv = g - 16, hv = gv >> 4, p_ = (gv & 15) * 1024 + lane * 16, st = p_ >> 9, y = p_ & 511, kk = (st >> 2) * 8 + (y >> 6), k = (kk & ~0xC) | ((kk & 4) << 1) | ((kk & 8) >> 1), cc = (st & 3) * 32 + ((y & 63) >> 1);
            soff[i] = (unsigned)(k * LDK * 2 + cc * 2 + hv * 256); } }
    const int lane16 = lane * 16;
#define DOF(i) (((lw + 6 * (i)) < 16 ? (lw + 6 * (i)) * 1024 : SHM_K + (((lw + 6 * (i)) - 16) >> 4) * SHM_V + (((lw + 6 * (i)) - 16) & 15) * 1024) + lane16)
    f32x4 ra[8], rb[8], rc[8], rd[8];
#define BARX() do { asm volatile("" ::: "memory"); __builtin_amdgcn_s_barrier(); asm volatile("" ::: "memory"); } while (0)
#define LD_TILE(t_, RA, RB) do { const int tt_ = (t_); const bool cache_ = tt_ < NC, vf32_ = cache_ && c == 0;     \
        const char* kb_ = cache_ ? (const char*)ckf + (size_t)tt_ * 64 * DM * 4 + c * HH * 4 : (const char*)K1 + c * HH * 2; \
        const char* vb_ = vf32_ ? (const char*)cvf + (size_t)tt_ * 64 * DM * 4 : (cache_ ? (const char*)cvb + (size_t)tt_ * 64 * DM * 2 : (const char*)V1); \
        _Pragma("unroll") for (int i = 0; i < 8; ++i) { const bool isk_ = (lw + 6 * i) < 16, f32_ = isk_ ? cache_ : vf32_; \
            const char* sp_ = (isk_ ? kb_ : vb_) + (f32_ ? 2u * soff[i] : soff[i]); RA[i] = *(const f32x4*)sp_; RB[i] = *(const f32x4*)(sp_ + 16); } } while (0)
#define ST_TILE(buf_, t_, RA, RB) do { const int tt_ = (t_); const bool cache_ = tt_ < NC, vf32_ = cache_ && c == 0; \
        _Pragma("unroll") for (int i = 0; i < 8; ++i) { const bool isk_ = (lw + 6 * i) < 16, f32_ = isk_ ? cache_ : vf32_; u32x4 w_; \
        if (f32_) { w_.x = cvt_pk_bf16(RA[i][0], RA[i][1]); w_.y = cvt_pk_bf16(RA[i][2], RA[i][3]); w_.z = cvt_pk_bf16(RB[i][0], RB[i][1]); w_.w = cvt_pk_bf16(RB[i][2], RB[i][3]); } \
        else { w_.x = __float_as_uint(RA[i][0]); w_.y = __float_as_uint(RA[i][1]); w_.z = __float_as_uint(RA[i][2]); w_.w = __float_as_uint(RA[i][3]); } \
        *(LAS u32x4*)(ldsl + (buf_) * TILE_B + DOF(i)) = w_; \
        if (vf32_ && !isk_) *(u32x4*)((char*)cvb + (size_t)tt_ * 64 * DM * 2 + soff[i]) = w_; } } while (0)
#pragma unroll 1
    for (int c = 0; c < 2; ++c) {
        asm volatile("s_waitcnt lgkmcnt(0)" ::: "memory"); BARX();
        LD_TILE(t_lo, ra, rb); LD_TILE(t_lo + 1, rc, rd);
        ST_TILE(0, t_lo, ra, rb); LD_TILE(t_lo + 2, ra, rb);
        ST_TILE(1, t_lo + 1, rc, rd); LD_TILE(t_lo + 3, rc, rd);
        asm volatile("s_waitcnt lgkmcnt(0)" ::: "memory"); BARX();
        int bsel = 0;
#pragma unroll 1
        for (int t = t_lo; t < NT; t += 2) {
            { const int bn = bsel == 0 ? 2 : bsel - 1;
              if (t + 2 < NT) ST_TILE(bn, t + 2, ra, rb);
              if (t + 4 < NT) LD_TILE(t + 4, ra, rb);
              asm volatile("s_waitcnt lgkmcnt(0)" ::: "memory"); BARX();
              bsel = bsel == 2 ? 0 : bsel + 1; }
            if (t + 1 >= NT) break;
            { const int bn = bsel == 0 ? 2 : bsel - 1;
              if (t + 3 < NT) ST_TILE(bn, t + 3, rc, rd);
              if (t + 5 < NT) LD_TILE(t + 5, rc, rd);
              asm volatile("s_waitcnt lgkmcnt(0)" ::: "memory"); BARX();
              bsel = bsel == 2 ? 0 : bsel + 1; }
        }
    }
    BARX();
#undef DOF
#undef LD_TILE
#undef ST_TILE
#undef BARX
}
}

#define XB_TMO      128
#define XB_XCNT(j)  (256  + 64 * (j))
#define XB_XSUB(j)  (1280 + 64 * (j))
#define XB_XGEN(j)  (2304 + 64 * (j))
#define XB_TOP      3328
#define XB_TOPGEN   3392
#define XCD_BAR_WORDS 3456
#define XB_SPIN_CAP (1u << 18)
__device__ __forceinline__ unsigned xb_ld(unsigned* p)              { return __hip_atomic_load(p, __ATOMIC_RELAXED, __HIP_MEMORY_SCOPE_AGENT); }
__device__ __forceinline__ unsigned xb_add(unsigned* p, unsigned v) { return __hip_atomic_fetch_add(p, v, __ATOMIC_RELAXED, __HIP_MEMORY_SCOPE_AGENT); }
__device__ __forceinline__ unsigned xb_xcc_id() { return (unsigned)__builtin_amdgcn_s_getreg((3 << 11) | 20) & 0xFu; }
#define XB_SPIN(cond, bar) do { unsigned _sp = 0; while (cond) { __builtin_amdgcn_s_sleep(1); \
    if ((++_sp & 255u) == 0u) { if (xb_ld(&(bar)[XB_TMO])) break; if (_sp > XB_SPIN_CAP) { atomicAdd(&(bar)[XB_TMO], 1u); break; } } } } while (0)
struct XcdBarrier { unsigned* bar; unsigned x; volatile LAS unsigned* st; };
__device__ __forceinline__ XcdBarrier xcd_barrier_post(unsigned* bar, volatile LAS unsigned* st, bool t0) {
    XcdBarrier b; b.bar = bar; b.x = xb_xcc_id(); b.st = st;
    if (t0) (void)xb_add(&bar[XB_XCNT(b.x)], 1u);
    return b;
}
__device__ __forceinline__ void xcd_barrier_complete(unsigned* bar, unsigned x, unsigned& nloc, unsigned& nx) {
    const unsigned G = gridDim.x * gridDim.y * gridDim.z;
    unsigned sum, cnt, mine, sp = 0u;
    for (;;) {
        sum = 0u; cnt = 0u; mine = 0u;
#pragma unroll
        for (unsigned j = 0; j < 16; ++j) { const unsigned c = xb_ld(&bar[XB_XCNT(j)]); sum += c; cnt += (c > 0u) ? 1u : 0u; mine = (j == x) ? c : mine; }
        if (sum == G) break;
        __builtin_amdgcn_s_sleep(1);
        if ((++sp & 255u) == 0u) { if (xb_ld(&bar[XB_TMO])) break; if (sp > XB_SPIN_CAP) { atomicAdd(&bar[XB_TMO], 1u); break; } }
    }
    nloc = mine > 0u ? mine : 1u; nx = cnt > 0u ? cnt : 1u;
}
__device__ __forceinline__ void xcd_barrier(const XcdBarrier& b, bool t0  ) {
    asm volatile("s_waitcnt vmcnt(0)" ::: "memory");
    __syncthreads();
    if (t0) {
        unsigned* bar = b.bar;
        __builtin_amdgcn_s_waitcnt(0);
        unsigned nloc = b.st[0], nx = b.st[1];
        if (nloc == 0u) { xcd_barrier_complete(bar, b.x, nloc, nx); b.st[0] = nloc; b.st[1] = nx; }
        const unsigned old = xb_add(&bar[XB_XSUB(b.x)], 1u);
        const unsigned gen = old / nloc;
        if (old + 1u == (gen + 1u) * nloc) {
            __builtin_amdgcn_fence(__ATOMIC_RELEASE, "agent");
            asm volatile("s_waitcnt vmcnt(0)" ::: "memory");
            const unsigned og = xb_add(&bar[XB_TOP], 1u);
            const unsigned tg = og / nx;
            if (og + 1u == (tg + 1u) * nx) xb_add(&bar[XB_TOPGEN], 1u);
            else XB_SPIN(xb_ld(&bar[XB_TOPGEN]) == tg, bar);
            __builtin_amdgcn_fence(__ATOMIC_ACQUIRE, "agent");
            xb_add(&bar[XB_XGEN(b.x)], 1u);
            asm volatile("s_waitcnt vmcnt(0)" ::: "memory");
        } else {
            XB_SPIN(xb_ld(&bar[XB_XGEN(b.x)]) == gen, bar);
            __builtin_amdgcn_fence(__ATOMIC_ACQUIRE, "agent");
            asm volatile("s_waitcnt vmcnt(0)" ::: "memory");
        }
    }
    __syncthreads();
}

__device__ __forceinline__ void transpose_item(const float* W, int N, bf16_t* WT, int ldt, int row_off, int mode, LAS float* scr, int item, int lane, const float* gain) {
    const int nblk = N / 32, kb = item / nblk, nb = item % nblk, k0 = 64 * kb, n0 = 32 * nb;
    const int c8 = lane & 7;
    f32x4 ga = (f32x4){1.f, 1.f, 1.f, 1.f}, gb = ga;
    if (gain != nullptr) { ga = *(const f32x4*)(gain + k0 + 8 * c8); gb = *(const f32x4*)(gain + k0 + 8 * c8 + 4); }
#pragma unroll 8
    for (int i = 0; i < 32; ++i) { const int kk = 2 * i + (lane >> 5); scr[kk * 33 + (lane & 31)] = W[(size_t)(k0 + kk) * N + n0 + (lane & 31)]; }
    LDS_WAIT(); asm volatile("" ::: "memory");
    const int rbase = mode == 0 ? row_off + n0 : ((n0 >> 7) * 256 + (n0 & 127) + (mode == 2 ? 128 : 0));
#pragma unroll
    for (int j = 0; j < 4; ++j) { const int n = (lane >> 3) + 8 * j; const LAS float* s = scr + (8 * c8) * 33 + n;
        u32x4 o; o.x = cvt_pk_bf16(s[0 * 33] * ga[0], s[1 * 33] * ga[1]); o.y = cvt_pk_bf16(s[2 * 33] * ga[2], s[3 * 33] * ga[3]); o.z = cvt_pk_bf16(s[4 * 33] * gb[0], s[5 * 33] * gb[1]); o.w = cvt_pk_bf16(s[6 * 33] * gb[2], s[7 * 33] * gb[3]);
        *(u32x4*)(WT + (size_t)(rbase + n) * ldt + k0 + 8 * c8) = o; }
    LDS_WAIT(); asm volatile("" ::: "memory");
}
__device__ __forceinline__ float row_rstd(const float* xrow, int lane) {
    const f32x4* xr = (const f32x4*)xrow + lane * 2; float ss = 0.f;
#pragma unroll
    for (int j = 0; j < 4; ++j) { const f32x4 a = xr[j * 128], b = xr[j * 128 + 1];
        ss += (a[0] * a[0] + a[1] * a[1]) + (a[2] * a[2] + a[3] * a[3]) + (b[0] * b[0] + b[1] * b[1]) + (b[2] * b[2] + b[3] * b[3]); }
    ss = wave_sum(ss);
    return __builtin_amdgcn_rsqf(ss * (1.0f / DM) + EPS);
}
__device__ __forceinline__ void fix_row(bf16_t* xrow, const float* prow  , u64* ssp, float* yrow, int lane) {
    float ssq = 0.f;
#pragma unroll
    for (int j = 0; j < 4; ++j) { const u32x4 w_ = *(const u32x4*)(xrow + j * 512 + lane * 8);
        f32x4 a = (f32x4){bf_lo(w_.x), bf_hi(w_.x), bf_lo(w_.y), bf_hi(w_.y)}, b = (f32x4){bf_lo(w_.z), bf_hi(w_.z), bf_lo(w_.w), bf_hi(w_.w)};
        const f32x4* pr = (const f32x4*)prow + j * 128 + lane * 2;
#pragma unroll
        for (int q = 0; q < 4; ++q) { a += pr[(size_t)q * (MS * DM / 4)]; b += pr[(size_t)q * (MS * DM / 4) + 1]; }
        if (yrow != nullptr) { ((f32x4*)yrow)[j * 128 + lane * 2] = a; ((f32x4*)yrow)[j * 128 + lane * 2 + 1] = b; }
        else { ssq += (a[0] * a[0] + a[1] * a[1]) + (a[2] * a[2] + a[3] * a[3]) + (b[0] * b[0] + b[1] * b[1]) + (b[2] * b[2] + b[3] * b[3]);
            u32x4 w; w.x = cvt_pk_bf16(a[0], a[1]); w.y = cvt_pk_bf16(a[2], a[3]); w.z = cvt_pk_bf16(b[0], b[1]); w.w = cvt_pk_bf16(b[2], b[3]);
            *(u32x4*)(xrow + j * 512 + lane * 8) = w; } }
    if (yrow == nullptr) { ssq = wave_sum(ssq); if (lane == 0) *ssp = (u64)(ssq * SS_SCALE); }
}

struct Args { const float* in[22]; float* out; unsigned char* ws; int ph_lo, ph_hi; };
constexpr int N_PHASES = 16;

__global__ void __launch_bounds__(512, 2) mk_fwd(Args args) {
    extern __shared__ __attribute__((aligned(16))) unsigned char lds_raw[];
    LAS unsigned char* lds = (LAS unsigned char*)lds_raw;
    volatile LAS unsigned* MISC = (volatile LAS unsigned*)(lds + MISC_OFF);
#define MK_TID() ((wv << 6) | lane_id_v())
#define PHASE_TID() int tid = MK_TID(); asm volatile("" : "+v"(tid)); const int lane = tid & 63, wave = __builtin_amdgcn_readfirstlane(tid >> 6), gw = vcu * 8 + wave; (void)lane; (void)gw
    const int G = gridDim.x, bx = blockIdx.x;
    const int vcu = (G % 8 == 0) ? (bx % 8) * (G / 8) + bx / 8 : bx;
    unsigned char* ws = args.ws;
    unsigned* ctl = (unsigned*)(ws + WS_CTL);
    int wv = __builtin_amdgcn_readfirstlane((int)threadIdx.x >> 6); asm volatile("" : "+s"(wv));
    for (int u = threadIdx.x; u < (LDS_BYTES - MISC_OFF) / 4; u += 512) ((LAS unsigned*)(lds + MISC_OFF))[u] = 0u;
    __syncthreads();
    XcdBarrier bar; bar.bar = ctl + CW_BAR; bar.x = 0; bar.st = nullptr;
    if (MK_N_LAUNCHES == 1) bar = xcd_barrier_post(ctl + CW_BAR, MISC + 8, threadIdx.x == 0);
    const int lo = args.ph_lo, hi = args.ph_hi; (void)lo; (void)hi;
#ifndef PHMASK
#define PHMASK 0xFFFF
#endif
#if MK_N_LAUNCHES == 1
#define IN(k) ((PHMASK >> (k)) & 1)
#else
#define IN(k) (((PHMASK >> (k)) & 1) && lo <= (k) && (k) < hi)
#endif
#define SEAM(k) do { if (IN(k) && IN((k) + 1)) { XcdBarrier b_ = bar; asm volatile("" : "+s"(b_.bar)); b_.x = xb_xcc_id(); xcd_barrier(b_, MK_TID() == 0); } } while (0)

    const float* x_prompt = args.in[0]; const float* x_sample = args.in[1]; const float* state_pool = args.in[2];
    const float* norm_mix = args.in[5]; const float* norm_ffn = args.in[6];
    float* Y = args.out + O_Y;
    float* rstd0 = (float*)(ws + WS_RSTD);
    bf16_t* Xb = (bf16_t*)(ws + WS_U); bf16_t* Hb = (bf16_t*)(ws + WS_H); bf16_t* Pb = (bf16_t*)(ws + WS_H);
    u64* ss1 = (u64*)(ctl + CW_SS);
    bf16_t* Qb = (bf16_t*)(ws + WS_Q); bf16_t* Kb = (bf16_t*)(ws + WS_K); bf16_t* Vb = (bf16_t*)(ws + WS_V);
    bf16_t* CKb = (bf16_t*)(ws + WS_CK); bf16_t* CVb = (bf16_t*)(ws + WS_CV);
    bf16_t* Wpool_t = (bf16_t*)(ws + WS_WPOOL); bf16_t* Wqkv_t = (bf16_t*)(ws + WS_WQKV); bf16_t* Wo_t = (bf16_t*)(ws + WS_WO);
    bf16_t* Wgu_t = (bf16_t*)(ws + WS_WGU); bf16_t* Wd_t = (bf16_t*)(ws + WS_WD);
    const int NGW = G * 8;

    if (IN(0)) {
        PHASE_TID();
        LAS float* scr = (LAS float*)(lds + wave * 16384);
        constexpr int I_QKV = (DM / 64) * (3 * DM / 32), I_O = (DM / 64) * (DM / 32), I_G = (DM / 64) * (DFF / 32), I_D = (DFF / 64) * (DM / 32), I_P = (512 / 64) * (512 / 32);
        constexpr int NITEMS = I_QKV + I_O + 4 * I_G + 2 * I_D + 4 * I_P;
        for (int it = gw; it < NITEMS; it += NGW) {
            int r = it;
            if (r < I_QKV) { transpose_item(args.in[10], 3 * DM, Wqkv_t, DM, 0, 0, scr, r, lane, norm_mix + DM); continue; } r -= I_QKV;
            if (r < I_O) { transpose_item(args.in[18], DM, Wo_t, DM, 0, 0, scr, r, lane, nullptr); continue; } r -= I_O;
            if (r < 4 * I_G) { const int q = r / I_G, layer = q >> 1, isup = q & 1;
                transpose_item((isup ? args.in[20] : args.in[19]) + (size_t)layer * DM * DFF, DFF, Wgu_t + (size_t)layer * 2 * DFF * DM, DM, 0, 1 + isup, scr, r - q * I_G, lane, norm_ffn + layer * DM); continue; } r -= 4 * I_G;
            if (r < 2 * I_D) { const int layer = r / I_D;
                transpose_item(args.in[21] + (size_t)layer * DFF * DM, DM, Wd_t + (size_t)layer * DM * DFF, DFF, 0, 0, scr, r - layer * I_D, lane, nullptr); continue; } r -= 2 * I_D;
            { const int gidx = r / I_P; transpose_item(args.in[7] + (size_t)gidx * 512 * 512, 512, Wpool_t, 512, gidx * 512, 0, scr, r - gidx * I_P, lane, nullptr); }
        }
        for (int m = gw; m < M; m += NGW) { const float* xr = m < MP ? x_prompt + (size_t)m * DM : x_sample + (size_t)(m - MP) * DM;
            const float r = row_rstd(xr, lane); if (lane == 0) rstd0[m] = r; }
    }
    SEAM(0);
    if (IN(1)) {
        PHASE_TID();
        const int c4 = tid * 4, w = 2 << (tid >> 7);
        const f32x4 g4 = *(const f32x4*)(norm_mix + c4);
        LAS f32x4* hist = (LAS f32x4*)lds + tid;
        for (int unit = vcu; unit < 512 + 256; unit += G) {
            const bool prompt = unit < 512;
            const int b = prompt ? (unit >> 7) : ((unit - 512) >> 3), t0 = prompt ? (unit & 127) * 64 : ((unit - 512) & 7) * 8, nt = prompt ? 64 : 8, T = prompt ? SEQ : DS;
            const int mb = prompt ? b * SEQ : MP + b * DS;
            const float* xb = prompt ? x_prompt + (size_t)b * SEQ * DM : x_sample + (size_t)b * DS * DM;
            const float* stp = state_pool + (size_t)b * PST * DM;
            float* pso = args.out + (prompt ? O_PSP : O_PSS) + (size_t)b * PST * DM;
#define EXT(j) ((j) >= 0 ? (*(const f32x4*)(xb + (size_t)(j) * DM + c4) * rstd0[mb + (j)] * g4) : (prompt ? (f32x4){0.f, 0.f, 0.f, 0.f} : *(const f32x4*)(stp + (size_t)(PST + (j)) * DM + c4)))
            f32x4 S = (f32x4){0.f, 0.f, 0.f, 0.f};
            for (int j = t0 - w + 1; j < t0; ++j) { const f32x4 u = EXT(j); hist[(j & 15) * 512] = u; S += u; }
#pragma unroll 1
            for (int tb = t0; tb < t0 + nt; tb += 8) {
                f32x4 xv[8]; float rs[8];
#pragma unroll
                for (int k = 0; k < 8; ++k) { xv[k] = *(const f32x4*)(xb + (size_t)(tb + k) * DM + c4); rs[k] = rstd0[mb + tb + k]; }
#pragma unroll
                for (int k = 0; k < 8; ++k) { const int t = tb + k;
                    const f32x4 u = xv[k] * rs[k] * g4; hist[(t & 15) * 512] = u; S += u;
                    const int cnt = prompt ? ((t + 1 < w) ? t + 1 : w) : w;
                    const f32x4 p = S * (1.0f / (float)cnt) - u;
                    u32x2 o; o.x = cvt_pk_bf16(p[0], p[1]); o.y = cvt_pk_bf16(p[2], p[3]);
                    *(u32x2*)(Pb + (size_t)(mb + t) * DM + c4) = o;
                    S -= hist[((t - w + 1) & 15) * 512];
                    if (t >= T - PST) *(f32x4*)(pso + (size_t)(t - (T - PST)) * DM + c4) = u; }
            }
#undef EXT
        }
    }
    SEAM(1);
    if (IN(2)) {
        pg8::Gemm g{Pb, Wpool_t, DM, 512, 512, 2, 512}; pg8::StaticOrder S; S.init(M, DM, G, bx);
        pg8::EpiPool E{x_prompt, x_sample, Xb, ss1, args.in[8], args.in[9]};
        pg8::gemm_phase<pg8::EpiPool>(lds, g, S, E, wv);
    }
    SEAM(2);
#pragma unroll 1
    for (int layer = 0; layer < 2; ++layer) {
        if (layer == 1) {
            if (IN(6)) { PHASE_TID(); for (int m = MP + gw; m < M; m += NGW) fix_row(Xb + (size_t)m * DM, (const float*)(ws + WS_SCR) + (size_t)(m - MP) * DM, ss1 + M + m, nullptr, lane); }
            SEAM(6);
            if (IN(7)) {
                pg8::Gemm g{Xb, Wqkv_t, DM, DM, DM, 1 << 20, 0}; pg8::StaticOrder S; S.init(M, 3 * DM, G, bx);
                pg8::EpiQKV E{Qb, args.out, args.in[11], args.in[12], (LAS float*)(lds + LDSX_OFF), ss1 + M};
                pg8::gemm_phase<pg8::EpiQKV>(lds, g, S, E, wv);
            }
            SEAM(7);
            if (IN(8)) {
                PHASE_TID();
                if (wave == 0) {
                    const float* lq1 = args.in[13]; const float* lk1 = args.in[14]; const float* lq2 = args.in[15]; const float* lk2 = args.in[16];
                    float s1 = lq1[lane] * lk1[lane] + lq1[lane + 64] * lk1[lane + 64], s2 = lq2[lane] * lk2[lane] + lq2[lane + 64] * lk2[lane + 64];
                    s1 = wave_sum(s1); s2 = wave_sum(s2);
                    float gq = fmaxf(fabsf(args.in[11][lane]), fabsf(args.in[11][lane + 64])), gk = fmaxf(fabsf(args.in[12][lane]), fabsf(args.in[12][lane + 64]));
                    gq = wave_max(gq); gk = wave_max(gk);
                    if (lane == 0) { ((volatile LAS float*)MISC)[16] = expf(s1) - expf(s2) + LAM_INIT;
                                     ((volatile LAS float*)MISC)[17] = 11.313708499f * 1.4426950408889634f * 1.02f * gq * gk + 0.25f; }
                }
                __syncthreads();
                const float M2 = ((volatile LAS float*)MISC)[17];
                float* scr = (float*)(ws + WS_SCR);
                LAS unsigned char* costs = (LAS unsigned char*)(lds + LDSX_OFF + 2048); LAS unsigned short* qtab = (LAS unsigned short*)(lds + LDSX_OFF + 2048 + 256);
                const int myx = (int)(xb_xcc_id() & 7u);
#pragma unroll 1
                for (int qq = 0; qq < 8; ++qq) {
                    const int q = (myx + qq) & 7;
                    __syncthreads();
                    { int tb = MK_TID(); asm volatile("" : "+v"(tb));
                      if (tb < att::ITEMS_PER_Q) costs[tb] = (unsigned char)att::att_cost(q, tb);
                      __syncthreads();
                      if (tb < att::ITEMS_PER_Q) { const int cj = costs[tb]; int rank = 0;
                          for (int i = 0; i < att::ITEMS_PER_Q; ++i) { const int ci = costs[i]; rank += (ci > cj || (ci == cj && i < tb)) ? 1 : 0; }
                          qtab[rank] = (unsigned short)tb; } }
                    __syncthreads();
#pragma unroll 1
                    for (;;) {
                        int tq = MK_TID(); asm volatile("" : "+v"(tq));
                        const int waveq = __builtin_amdgcn_readfirstlane(tq >> 6);
                        if (tq == 0) MISC[20] = __hip_atomic_fetch_add(ctl + CW_Q + 64 * q, 1u, __ATOMIC_RELAXED, __HIP_MEMORY_SCOPE_AGENT);
                        __syncthreads();
                        const unsigned idx = MISC[20];
                        __syncthreads();
                        if (idx >= (unsigned)att::ITEMS_PER_Q) break;
                        const int j = qtab[idx];
                        bool prompt; int b, h, qb; att::att_item(q, j, prompt, b, h, qb);
                        att::UnitDesc U;
                        const size_t mrow = prompt ? (size_t)b * SEQ + (size_t)qb * 256 : (size_t)MP + (size_t)b * DS;
                        U.Q = Qb + mrow * DM + h * HD; U.O = Qb + mrow * DM + h * HD;
                        U.K1 = Kb + (prompt ? (size_t)b * SEQ : mrow) * DM + h * HD; U.V1 = Vb + (prompt ? (size_t)b * SEQ : mrow) * DM + h * HD;
                        U.K0 = prompt ? U.K1 : CKb + (size_t)b * PAST * DM + h * HD; U.V0 = prompt ? U.V1 : CVb + (size_t)b * PAST * DM + h * HD;
                        U.NT = prompt ? 4 * qb + 4 : PAST / 64 + 1; U.nt0 = prompt ? U.NT : PAST / 64;
                        U.t_lo = att::att_tlo(prompt ? qb * 256 : PAST, h);
                        U.ntw = prompt ? 4 * qb + (waveq >> 1) + 1 : (waveq < 2 ? PAST / 64 + 1 : 0);
                        U.qbase = (prompt ? qb * 256 : PAST) + waveq * 32;
                        U.slope2 = exp2f(-(float)(h + 1)) * 1.4426950408889634f;
                        U.nodma = !prompt;
                        if (!prompt && waveq >= 2) att::loader_unit(args.in[3] + (size_t)b * PAST * DM + h * HD, args.in[4] + (size_t)b * PAST * DM + h * HD, CVb + (size_t)b * PAST * DM + h * HD, U.K1, U.V1, U.t_lo, (char*)lds_raw, wv);
                        else
                        att::attn_unit(U, (const volatile LAS float*)MISC + 16, M2, args.in[17], scr, (char*)lds_raw, wv);
                    }
                }
                __syncthreads();
            }
            SEAM(8);
            if (IN(9)) {
                pg8::Gemm g{Qb, Wo_t, DM, DM, DM, 1 << 20, 0}; pg8::StaticOrder S; S.init(M, DM, G, bx, MS / 256, 4);
                pg8::EpiRes E{Xb, ss1 + 2 * M, (float*)(ws + WS_SCR), nullptr};
                pg8::gemm_phase<pg8::EpiRes>(lds, g, S, E, wv);
            }
            SEAM(9);
            if (IN(10)) { PHASE_TID(); for (int m = MP + gw; m < M; m += NGW) fix_row(Xb + (size_t)m * DM, (const float*)(ws + WS_SCR) + (size_t)(m - MP) * DM, ss1 + 2 * M + m, nullptr, lane); }
            SEAM(10);
        }
        const int p_gu = layer == 0 ? 4 : 11, p_dn = layer == 0 ? 5 : 12;
        if (IN(p_gu)) {
            pg8::Gemm g{Xb, Wgu_t + (size_t)layer * 2 * DFF * DM, DM, DM, DM, 1 << 20, 0}; pg8::StaticOrder S; S.init(M, 2 * DFF, G, bx, 0, 1, 1);
            pg8::EpiSwiglu E{Hb, ss1 + (size_t)layer * 2 * M};
            pg8::gemm_phase<pg8::EpiSwiglu>(lds, g, S, E, wv);
        }
        SEAM(p_gu);
        if (IN(p_dn)) {
            pg8::Gemm g{Hb, Wd_t + (size_t)layer * DM * DFF, DFF, DFF, DFF, 1 << 20, 0}; pg8::StaticOrder S; S.init(M, DM, G, bx, MS / 256, 4);
            pg8::EpiRes E{Xb, ss1 + M, (float*)(ws + WS_SCR), layer == 1 ? Y : nullptr};
            pg8::gemm_phase<pg8::EpiRes>(lds, g, S, E, wv);
        }
        SEAM(p_dn);
    }
    if (IN(13)) { PHASE_TID(); for (int m = MP + gw; m < M; m += NGW) fix_row(Xb + (size_t)m * DM, (const float*)(ws + WS_SCR) + (size_t)(m - MP) * DM, nullptr, Y + (size_t)m * DM, lane); }
#undef IN
#undef SEAM
}

extern "C" void kernel_launch(void* const* d_in, const int* in_sizes, int n_in, void* d_out, int out_size, void* d_ws, size_t ws_size, hipStream_t stream) {
    static int grid = 0;
    if (grid == 0) {
        if (n_in != 22 || in_sizes[0] != MP * DM || (size_t)out_size != O_END || ws_size < WS_END) {
            fprintf(stderr, "kernel_launch: shape mismatch: n_in %d in0 %d out %d ws %zu (need %zu)\n", n_in, n_in > 0 ? in_sizes[0] : -1, out_size, ws_size, (size_t)WS_END); grid = -1; return; }
        int dev = 0, cus = 0, per_cu = 0;
        if (hipGetDevice(&dev) != hipSuccess || hipDeviceGetAttribute(&cus, hipDeviceAttributeMultiprocessorCount, dev) != hipSuccess) { grid = -1; return; }
        if (hipFuncSetAttribute((const void*)mk_fwd, hipFuncAttributeMaxDynamicSharedMemorySize, LDS_BYTES) != hipSuccess) { fprintf(stderr, "kernel_launch: hipFuncSetAttribute failed\n"); grid = -1; return; }
        if (hipOccupancyMaxActiveBlocksPerMultiprocessor(&per_cu, (const void*)mk_fwd, 512, LDS_BYTES) != hipSuccess || per_cu < 1) {
            fprintf(stderr, "kernel_launch: occupancy query reports %d workgroups per CU\n", per_cu); }
        (void)hipGetLastError();
        grid = cus;
    }
    if (grid < 0) return;
    if (hipMemsetAsync((char*)d_ws + WS_CTL, 0, CTL_ZERO_BYTES, stream) != hipSuccess) { fprintf(stderr, "kernel_launch: memset failed\n"); return; }
    Args a{};
    for (int i = 0; i < 22; ++i) a.in[i] = (const float*)d_in[i];
    a.out = (float*)d_out; a.ws = (unsigned char*)d_ws;
#if MK_N_LAUNCHES == 1
    a.ph_lo = 0; a.ph_hi = N_PHASES;
    hipLaunchKernelGGL(mk_fwd, dim3(grid), dim3(512), LDS_BYTES, stream, a);
#else
    for (int p = 0; p < 14; ++p) { a.ph_lo = p; a.ph_hi = p + 1; hipLaunchKernelGGL(mk_fwd, dim3(grid), dim3(512), LDS_BYTES, stream, a); }
#endif
    const hipError_t le = hipPeekAtLastError();
    if (le != hipSuccess) fprintf(stderr, "kernel_launch: launch failed: %s\n", hipGetErrorName(le));
}
```
